# Optimizing an MI355X kernel written in HIP

```python
import math
import jax, jax.numpy as jnp
from jax import lax
import numpy as np

D_MODEL = 1024
BATCH = 16
SEQ = 2048
DEPTH = 1

MEM_LEN = 256
MIX_WIDTH = D_MODEL
ML_HEADS = 4
ML_WIDTH = MIX_WIDTH // 2
ML_HEAD_DIM = ML_WIDTH // ML_HEADS
ML_CONV = 4
ML_CHUNK = 64
DSA_HEADS = 8
DSA_WIDTH = MIX_WIDTH - ML_WIDTH
DSA_HEAD_DIM = DSA_WIDTH // DSA_HEADS
DSA_LATENT = D_MODEL // 8
IDX_HEADS = 8
IDX_DIM = 64
INDEX_TOPK = 256
Q_BLOCK = 128
XA_HEADS = 4
XA_HEAD_DIM = D_MODEL // XA_HEADS
D_FF = ((8 * D_MODEL // 3 + 127) // 128) * 128
EPS = 1e-6

IN_SPLITS = (ML_WIDTH, ML_WIDTH, ML_WIDTH, ML_HEADS, ML_HEADS, ML_WIDTH,
             DSA_HEADS * DSA_LATENT, DSA_LATENT, IDX_HEADS * IDX_DIM, IDX_DIM, IDX_HEADS)
D_IN = sum(IN_SPLITS)

kernel_name = "hymba_mlstm_dsa_macaron"

F32 = jnp.float32


def rmsnorm(x, g):
    xf = x.astype(F32)
    y = xf * lax.rsqrt(jnp.mean(xf * xf, axis=-1, keepdims=True) + EPS)
    return (y * g.astype(F32)).astype(x.dtype)


def swiglu(x, w_gate, w_up, w_down):
    return (jax.nn.silu(x @ w_gate) * (x @ w_up)) @ w_down


def causal_dwconv(x, w, b):
    k = w.shape[0]
    y = lax.conv_general_dilated(x, w[:, None, :].astype(x.dtype), window_strides=(1,),
                                 padding=[(k - 1, 0)],
                                 dimension_numbers=('NWC', 'WIO', 'NWC'),
                                 feature_group_count=x.shape[-1])
    return y + b.astype(x.dtype)


def mlstm_chunkwise(q, k, v, ig, lf):
    B, H, S, d = q.shape
    L = ML_CHUNK
    nc = S // L
    ch = lambda t: jnp.moveaxis(t.reshape(B, H, nc, L, *t.shape[3:]), 2, 0)
    causal = jnp.tril(jnp.ones((L, L), dtype=bool))

    def step(carry, inp):
        C, n, m = carry
        qc, kc, vc, ic, fc = inp
        b = jnp.cumsum(fc, axis=-1)
        logw = jnp.where(causal, b[..., :, None] - b[..., None, :] + ic[..., None, :], -jnp.inf)
        inter = b + m[..., None]
        mj = jnp.maximum(inter, jnp.max(logw, axis=-1))
        w = jnp.exp(logw - mj[..., None])
        a = jnp.exp(inter - mj)
        sqk = jnp.einsum('bhjd,bhsd->bhjs', qc, kc) * w
        num = a[..., None] * jnp.einsum('bhed,bhjd->bhje', C, qc) + jnp.einsum('bhjs,bhse->bhje', sqk, vc)
        den = a * jnp.einsum('bhd,bhjd->bhj', n, qc) + jnp.sum(sqk, axis=-1)
        h = num / jnp.maximum(jnp.abs(den), jnp.exp(-mj))[..., None]
        bL = b[..., -1]
        g = bL[..., None] - b + ic
        m_new = jnp.maximum(bL + m, jnp.max(g, axis=-1))
        wg = jnp.exp(g - m_new[..., None])
        dec = jnp.exp(bL + m - m_new)
        C = dec[..., None, None] * C + jnp.einsum('bhs,bhse,bhsd->bhed', wg, vc, kc)
        n = dec[..., None] * n + jnp.einsum('bhs,bhsd->bhd', wg, kc)
        return (C, n, m_new), h

    init = (jnp.zeros((B, H, d, d), F32), jnp.zeros((B, H, d), F32), jnp.zeros((B, H), F32))
    _, hs = lax.scan(step, init, (ch(q), ch(k), ch(v), ch(ig), ch(lf)))
    return jnp.moveaxis(hs, 0, 2).reshape(B, H, S, d)


def mlstm_group(q, k, v, i_pre, f_pre, o_pre, head_g):
    B, S, _ = q.shape
    heads = lambda t: t.reshape(B, S, ML_HEADS, ML_HEAD_DIM).transpose(0, 2, 1, 3).astype(F32)
    qh = heads(q)
    kh = heads(k) * (ML_HEAD_DIM ** -0.5)
    vh = heads(v)
    ig = i_pre.astype(F32).transpose(0, 2, 1)
    lf = jax.nn.log_sigmoid(f_pre.astype(F32)).transpose(0, 2, 1)
    h = mlstm_chunkwise(qh, kh, vh, ig, lf).transpose(0, 2, 1, 3)
    h = rmsnorm(h, head_g.reshape(ML_HEADS, ML_HEAD_DIM))
    h = h.reshape(B, S, ML_WIDTH) * jax.nn.sigmoid(o_pre.astype(F32))
    return h.astype(q.dtype)


def dsa_group(dq, dc, iq, ik, iw, kv_g, idx_g, w_uv):
    B, S, _ = dq.shape
    qm = dq.reshape(B, S, DSA_HEADS, DSA_LATENT)
    ckv = rmsnorm(dc, kv_g)
    qi = iq.reshape(B, S, IDX_HEADS, IDX_DIM)
    ki = rmsnorm(ik, idx_g)
    wi = iw.astype(F32) * (IDX_HEADS ** -0.5)
    topk = min(INDEX_TOPK, S // 4)
    nb = S // Q_BLOCK
    blk = lambda t: jnp.moveaxis(t.reshape(B, nb, Q_BLOCK, *t.shape[2:]), 1, 0)
    key_pos = jnp.arange(S)

    def one_block(args):
        bi, qm_b, qi_b, wi_b = args
        qpos = bi * Q_BLOCK + jnp.arange(Q_BLOCK)
        sc = jnp.einsum('bqhd,bsd->bqhs', qi_b, ki).astype(F32) * (IDX_DIM ** -0.5)
        score = jnp.einsum('bqh,bqhs->bqs', wi_b, jax.nn.relu(sc))
        causal = key_pos[None, :] <= qpos[:, None]
        score = jnp.where(causal[None], score, -jnp.inf)
        _, idx = lax.top_k(score, topk)
        valid = idx <= qpos[None, :, None]
        kv = jax.vmap(lambda c, i: c[i])(ckv, idx)
        lg = jnp.einsum('bqhc,bqkc->bqhk', qm_b, kv).astype(F32) * (DSA_LATENT ** -0.5)
        lg = jnp.where(valid[:, :, None, :], lg, -jnp.inf)
        p = jax.nn.softmax(lg, axis=-1).astype(kv.dtype)
        return jnp.einsum('bqhk,bqkc->bqhc', p, kv)

    o = lax.map(one_block, (jnp.arange(nb), blk(qm), blk(qi), blk(wi)))
    o = jnp.moveaxis(o, 0, 1).reshape(B, S, DSA_HEADS, DSA_LATENT)
    return jnp.einsum('bshc,hcv->bshv', o, w_uv).reshape(B, S, DSA_WIDTH)


def cross_attn(u, memn, w_q, w_kv, w_o):
    B, S, _ = u.shape
    M = memn.shape[1]
    q = (u @ w_q).reshape(B, S, XA_HEADS, XA_HEAD_DIM)
    k, v = jnp.split(memn @ w_kv, 2, axis=-1)
    k = k.reshape(B, M, XA_HEADS, XA_HEAD_DIM)
    v = v.reshape(B, M, XA_HEADS, XA_HEAD_DIM)
    lg = jnp.einsum('bshd,bmhd->bhsm', q, k).astype(F32) * (XA_HEAD_DIM ** -0.5)
    p = jax.nn.softmax(lg, axis=-1).astype(v.dtype)
    o = jnp.einsum('bhsm,bmhd->bshd', p, v).reshape(B, S, D_MODEL)
    return o @ w_o


def setup_inputs(seed: int = 0) -> dict:
    key = jax.random.key(seed)
    ks = jax.random.split(key, 32)
    nrm = lambda k, shape, s: jax.random.normal(k, shape, F32) * s
    gain = lambda k, shape: 1.0 + 0.02 * jax.random.normal(k, shape, F32)
    L = DEPTH
    return {
        "x": nrm(ks[0], (BATCH, SEQ, D_MODEL), 1.0),
        "mem": nrm(ks[1], (BATCH, MEM_LEN, D_MODEL), 1.0),
        "ffn1_norm_g": gain(ks[2], (L, D_MODEL)),
        "ffn1_w_gate": nrm(ks[3], (L, D_MODEL, D_FF), D_MODEL ** -0.5),
        "ffn1_w_up": nrm(ks[4], (L, D_MODEL, D_FF), D_MODEL ** -0.5),
        "ffn1_w_down": nrm(ks[5], (L, D_FF, D_MODEL), D_FF ** -0.5),
        "mix_norm_g": gain(ks[6], (L, D_MODEL)),
        "w_in": nrm(ks[7], (L, D_MODEL, D_IN), D_MODEL ** -0.5),
        "mlstm_conv_w": nrm(ks[8], (L, ML_CONV, 2 * ML_WIDTH), ML_CONV ** -0.5),
        "mlstm_conv_b": nrm(ks[9], (L, 2 * ML_WIDTH), 0.02),
        "mlstm_i_bias": nrm(ks[10], (L, ML_HEADS), 0.1),
        "mlstm_f_bias": jnp.linspace(3.0, 6.0, ML_HEADS, dtype=F32)[None, :] + nrm(ks[11], (L, ML_HEADS), 0.1),
        "mlstm_head_norm_g": gain(ks[12], (L, ML_WIDTH)),
        "dsa_kv_norm_g": gain(ks[13], (L, DSA_LATENT)),
        "idx_k_norm_g": gain(ks[14], (L, IDX_DIM)),
        "dsa_w_uv": nrm(ks[15], (L, DSA_HEADS, DSA_LATENT, DSA_HEAD_DIM), DSA_LATENT ** -0.5),
        "w_out": nrm(ks[16], (L, MIX_WIDTH, D_MODEL), MIX_WIDTH ** -0.5),
        "xattn_norm_g": gain(ks[17], (L, D_MODEL)),
        "mem_norm_g": gain(ks[18], (L, D_MODEL)),
        "xattn_w_q": nrm(ks[19], (L, D_MODEL, D_MODEL), D_MODEL ** -0.5),
        "xattn_w_kv": nrm(ks[20], (L, D_MODEL, 2 * D_MODEL), D_MODEL ** -0.5),
        "xattn_w_o": nrm(ks[21], (L, D_MODEL, D_MODEL), D_MODEL ** -0.5),
        "ffn2_norm_g": gain(ks[22], (L, D_MODEL)),
        "ffn2_w_gate": nrm(ks[23], (L, D_MODEL, D_FF), D_MODEL ** -0.5),
        "ffn2_w_up": nrm(ks[24], (L, D_MODEL, D_FF), D_MODEL ** -0.5),
        "ffn2_w_down": nrm(ks[25], (L, D_FF, D_MODEL), D_FF ** -0.5),
        "final_norm_g": gain(ks[26], (D_MODEL,)),
    }


def reference(x, mem, ffn1_norm_g, ffn1_w_gate, ffn1_w_up, ffn1_w_down, mix_norm_g, w_in,
              mlstm_conv_w, mlstm_conv_b, mlstm_i_bias, mlstm_f_bias, mlstm_head_norm_g,
              dsa_kv_norm_g, idx_k_norm_g, dsa_w_uv, w_out, xattn_norm_g, mem_norm_g,
              xattn_w_q, xattn_w_kv, xattn_w_o, ffn2_norm_g, ffn2_w_gate, ffn2_w_up,
              ffn2_w_down, final_norm_g):
    offsets = [int(c) for c in np.cumsum(IN_SPLITS)[:-1]]
    h = x
    for l in range(DEPTH):
        h = h + 0.5 * swiglu(rmsnorm(h, ffn1_norm_g[l]), ffn1_w_gate[l], ffn1_w_up[l], ffn1_w_down[l])
        u = rmsnorm(h, mix_norm_g[l])
        z = u @ w_in[l]
        mq, mk, mv, mi, mf, mo, dq, dc, iq, ik, iw = jnp.split(z, offsets, axis=-1)
        qk = jax.nn.silu(causal_dwconv(jnp.concatenate([mq, mk], axis=-1), mlstm_conv_w[l], mlstm_conv_b[l]))
        mq, mk = jnp.split(qk, 2, axis=-1)
        y_ml = mlstm_group(mq, mk, mv, mi + mlstm_i_bias[l], mf + mlstm_f_bias[l], mo, mlstm_head_norm_g[l])
        y_dsa = dsa_group(dq, dc, iq, ik, iw, dsa_kv_norm_g[l], idx_k_norm_g[l], dsa_w_uv[l])
        h = h + jnp.concatenate([y_ml, y_dsa], axis=-1) @ w_out[l]
        h = h + cross_attn(rmsnorm(h, xattn_norm_g[l]), rmsnorm(mem, mem_norm_g[l]),
                           xattn_w_q[l], xattn_w_kv[l], xattn_w_o[l])
        h = h + 0.5 * swiglu(rmsnorm(h, ffn2_norm_g[l]), ffn2_w_gate[l], ffn2_w_up[l], ffn2_w_down[l])
    return rmsnorm(h, final_norm_g)
```

```cpp
#include <hip/hip_runtime.h>
#include <hip/hip_cooperative_groups.h>
#include <cstdio>
#include <cstdint>
namespace cg = cooperative_groups;
namespace pg8 {
#define PG8_LAS __attribute__((address_space(3)))
typedef unsigned short bf16_t;
typedef short bf16x8 __attribute__((ext_vector_type(8)));
typedef float f32x4 __attribute__((ext_vector_type(4)));
typedef unsigned u32x4 __attribute__((ext_vector_type(4)));
constexpr int BM = 256, BK = 64, HALF = 128, HTB = HALF * BK * 2  , STAGE_BYTES = 8 * HTB, NXCD = 8, WGM = 8;

__host__ __device__ __forceinline__ int lds_byte(int r, int c) { const int st = (r >> 4) * 2 + (c >> 5), rr = r & 15, cc = c & 31, ob = rr * 64 + cc * 2; return st * 1024 + (ob ^ (((ob >> 9) & 1) << 5)); }
__host__ __device__ __forceinline__ void stage_rc(int b, int& R, int& C) { const int st = b / 1024, sb = b % 1024, swz = sb ^ (((sb >> 9) & 1) << 5); R = (st >> 1) * 16 + swz / 64; C = (st & 1) * 32 + (swz % 64) / 2; }
__host__ __device__ __forceinline__ int perm32(int rho) { const int n = rho >> 4, i = rho & 15; return 8 * (i >> 2) + 4 * n + (i & 3); }

struct Unit { int pm, pn; };
struct Gemm { const bf16_t* A; const bf16_t* Bt; int M, N, K; };

struct StaticOrder {
    int nM, nN, nwg, G, c;
    __host__ __device__ void init(int M, int N, int G_, int c_) { nM = M / BM; nN = N / BM; nwg = nM * nN; G = G_; c = c_; }
    __host__ __device__ bool next(int i, Unit& u) const {
        const long L = (long)i * G + c; if (L >= nwg) return false;
        int wgid = (int)L; { const int q = nwg / NXCD, r = nwg % NXCD, xcd = wgid % NXCD, off = wgid / NXCD; wgid = (xcd < r ? xcd * (q + 1) : r * (q + 1) + (xcd - r) * q) + off; }
        const int nig = WGM * nN, gid = wgid / nig, fm = gid * WGM, gsz = (nM - fm) < WGM ? (nM - fm) : WGM;
        u.pm = fm + ((wgid % nig) % gsz); u.pn = (wgid % nig) / gsz; return true;
    }
    __device__ __forceinline__ void a_ready(const Unit&) const {}
    __device__ __forceinline__ void done(const Unit&) const {}
};

__device__ __forceinline__ unsigned cvt_pk_bf16(float lo, float hi) { unsigned r; asm volatile("v_cvt_pk_bf16_f32 %0, %1, %2" : "=v"(r) : "v"(lo), "v"(hi)); return r; }
#define PG8_GAS __attribute__((address_space(1)))
constexpr float RMS_EPS = 1e-6f;
__device__ __forceinline__ unsigned f2bf_(float f) { unsigned u = __builtin_bit_cast(unsigned, f); return (u + 0x7fffu + ((u >> 16) & 1u)) >> 16; }
typedef float f32x2c_t __attribute__((ext_vector_type(2))); typedef __bf16 bf16x2c_t __attribute__((ext_vector_type(2)));
__device__ __forceinline__ unsigned pk2_(float lo, float hi) { f32x2c_t v = {lo, hi}; bf16x2c_t b = __builtin_convertvector(v, bf16x2c_t); return __builtin_bit_cast(unsigned, b); }
__device__ __forceinline__ float row_rstd(const float* parts, int r, int fq) {
    const f32x4 p = *(const PG8_GAS f32x4*)(parts + (size_t)r * 16 + 4 * fq);
    float s = (p[0] + p[1]) + (p[2] + p[3]);
    s += __shfl_xor(s, 16); s += __shfl_xor(s, 32);
    return rsqrtf(s * (1.0f / 1024.0f) + RMS_EPS);
}
__device__ __forceinline__ float silu_f(float x) { return x * __builtin_amdgcn_rcpf(1.0f + __builtin_amdgcn_exp2f(-1.4426950408889634f * x)); }
struct EpiAct {
    static constexpr bool PERM = true, AFTER_DRAIN = false;
    bf16_t* O; const float* parts;
    __device__ __forceinline__ void operator()(const f32x4 (&acc)[2][2][4][2], const Unit& u, int wr, int wc, int fr, int fq) const {
        const int row0 = u.pm * BM + wr * 64 + fr, col0 = u.pn * 128 + wc * 32 + 8 * fq;
        float rs8[2][4];
#pragma unroll
        for (int ai = 0; ai < 2; ++ai)
#pragma unroll
            for (int m = 0; m < 4; ++m) rs8[ai][m] = row_rstd(parts, row0 + ai * HALF + m * 16, fq);
#pragma unroll
        for (int ai = 0; ai < 2; ++ai)
#pragma unroll
            for (int m = 0; m < 4; ++m) {
                const int r = row0 + ai * HALF + m * 16; const float s = rs8[ai][m];
                float o[8];
#pragma unroll
                for (int n = 0; n < 2; ++n)
#pragma unroll
                    for (int i = 0; i < 4; ++i) o[4 * n + i] = silu_f(acc[ai][0][m][n][i] * s) * (acc[ai][1][m][n][i] * s);
                u32x4 w; w.x = pk2_(o[0], o[1]); w.y = pk2_(o[2], o[3]); w.z = pk2_(o[4], o[5]); w.w = pk2_(o[6], o[7]);
                *(PG8_GAS u32x4*)(O + (size_t)r * 2816 + col0) = w;
            }
    }
};
template <int MODE> struct EpiScale {
    static constexpr bool PERM = true, AFTER_DRAIN = false;
    bf16_t* O; int ldc; const float* sc;
    __device__ __forceinline__ void operator()(const f32x4 (&acc)[2][2][4][2], const Unit& u, int wr, int wc, int fr, int fq) const {
        const int row0 = u.pm * BM + wr * 64 + fr, col0 = u.pn * BM + wc * 32 + 8 * fq;
        float rs8[2][4];
#pragma unroll
        for (int ai = 0; ai < 2; ++ai)
#pragma unroll
            for (int m = 0; m < 4; ++m) { const int r = row0 + ai * HALF + m * 16; rs8[ai][m] = MODE == 0 ? row_rstd(sc, r, fq) : (MODE == 1 ? ((const PG8_GAS float*)sc)[r] : 1.f); }
        f32x4 cs[2][2];
        if (MODE == 2) {
#pragma unroll
            for (int bj = 0; bj < 2; ++bj)
#pragma unroll
                for (int n = 0; n < 2; ++n) cs[bj][n] = *(const PG8_GAS f32x4*)(sc + col0 + bj * HALF + 4 * n);
        }
#pragma unroll
        for (int ai = 0; ai < 2; ++ai)
#pragma unroll
            for (int m = 0; m < 4; ++m) {
                const int r = row0 + ai * HALF + m * 16;
                const float s = rs8[ai][m];
#pragma unroll
                for (int bj = 0; bj < 2; ++bj) {
                    f32x4 v0 = acc[ai][bj][m][0], v1 = acc[ai][bj][m][1];
                    if (MODE == 2) { v0 = v0 * cs[bj][0]; v1 = v1 * cs[bj][1]; } else { v0 = v0 * s; v1 = v1 * s; }
                    u32x4 w; w.x = pk2_(v0[0], v0[1]); w.y = pk2_(v0[2], v0[3]); w.z = pk2_(v1[0], v1[1]); w.w = pk2_(v1[2], v1[3]);
                    *(PG8_GAS u32x4*)(O + (size_t)r * ldc + col0 + bj * HALF) = w;
                }
            }
    }
};
template <bool BASE_F32> struct EpiResid {
    static constexpr bool PERM = false, AFTER_DRAIN = false;
    const float* base; const bf16_t* hbase; bf16_t* hb; float* parts; float alpha;
    __device__ __forceinline__ void operator()(const f32x4 (&acc)[2][2][4][2], const Unit& u, int wr, int wc, int fr, int fq) const {
        typedef unsigned u32x2v __attribute__((ext_vector_type(2)));
        const int row0 = u.pm * BM + wr * 64 + fr, col0 = u.pn * BM + wc * 32 + 4 * fq;
        u32x2v bsv[2][4][2][2];
#pragma unroll
        for (int ai = 0; ai < 2; ++ai)
#pragma unroll
            for (int m = 0; m < 4; ++m) { const size_t off = (size_t)(row0 + ai * HALF + m * 16) * 1024 + col0;
#pragma unroll
                for (int bj = 0; bj < 2; ++bj)
#pragma unroll
                    for (int n = 0; n < 2; ++n) bsv[ai][m][bj][n] = *(const PG8_GAS u32x2v*)(hbase + off + bj * HALF + n * 16); }
#pragma unroll
        for (int ai = 0; ai < 2; ++ai)
#pragma unroll
            for (int m = 0; m < 4; ++m) {
                const int r = row0 + ai * HALF + m * 16; const size_t off = (size_t)r * 1024 + col0; float ss = 0.f;
#pragma unroll
                for (int bj = 0; bj < 2; ++bj)
#pragma unroll
                    for (int n = 0; n < 2; ++n) {
                        const u32x2v w0 = bsv[ai][m][bj][n]; f32x4 bs;
                        bs[0] = __builtin_bit_cast(float, w0.x << 16); bs[1] = __builtin_bit_cast(float, w0.x & 0xffff0000u); bs[2] = __builtin_bit_cast(float, w0.y << 16); bs[3] = __builtin_bit_cast(float, w0.y & 0xffff0000u);
                        const f32x4 v = bs + acc[ai][bj][m][n] * alpha;
                        { u32x2v w; w.x = pk2_(v[0], v[1]); w.y = pk2_(v[2], v[3]); *(PG8_GAS u32x2v*)(hb + off + bj * HALF + n * 16) = w; }
                        ss += (v[0] * v[0] + v[1] * v[1]) + (v[2] * v[2] + v[3] * v[3]);
                    }
                ss += __shfl_xor(ss, 16); ss += __shfl_xor(ss, 32);
                if (fq == 0) ((PG8_GAS float*)parts)[(size_t)r * 16 + u.pn * 4 + wc] = ss;
            }
    }
};
struct RangeOrder {
    int n, nN, G, c0;
    __device__ void init(int nM_, int nN_, int G_, int c_, int shift) { n = nM_ * nN_; nN = nN_; G = G_; c0 = (c_ + G_ - (shift % G_)) % G_; }
    __device__ bool next(int i, Unit& u) const { const long L = (long)i * G + c0; if (L >= n) return false; u.pm = (int)L / nN; u.pn = (int)L % nN; return true; }
    __device__ __forceinline__ void a_ready(const Unit&) const {}
    __device__ __forceinline__ void done(const Unit&) const {}
};
template <class Epi, class Sched, bool ALIGN_EPI = false, bool SP2 = false>
__device__ __forceinline__ void gemm_phase(PG8_LAS unsigned char* lds, const Gemm g, const Sched& S, const Epi& E) {
    int tid_ = threadIdx.x; asm volatile("" : "+v"(tid_));
    const int tid = tid_, wid = __builtin_amdgcn_readfirstlane(tid >> 6), lane = tid & 63, wr = wid >> 2, wc = wid & 3, fr = lane & 15, fq = lane >> 4;
    const int K = g.K, nt = K / BK;
    unsigned voffA, voffB;
    { int R, C; stage_rc(tid * 16, R, C); const int Rb = Epi::PERM ? ((R & ~31) + perm32(R & 31)) : R;
      voffA = (unsigned)(R * K + C) * 2u; voffB = (unsigned)(Rb * K + C) * 2u; }
    const size_t rstep64 = (size_t)64 * K * 2;
    const size_t kstep = (size_t)(BK * 2);
    const size_t hstep = (size_t)HALF * K * 2;
    const size_t tstep = 2 * hstep;
    const unsigned ldsw = (unsigned)wid * 1024u;
    const int aoff = lds_byte(wr * 64 + fr, fq * 8), boff = lds_byte(wc * 32 + fr, fq * 8);
#define PG8_SA(b, h) (((b) * 2 + (h)) * HTB)
#define PG8_SB(b, h) ((4 + (b) * 2 + (h)) * HTB)
#define PG8_STAGE(bufoff, gbase, voff) do { _Pragma("unroll") for (int _i = 0; _i < 2; ++_i) \
        __builtin_amdgcn_global_load_lds((const unsigned*)(((const char*)(gbase) + _i * rstep64) + (voff)), (PG8_LAS unsigned*)(lds + (bufoff) + ldsw + _i * 8192), 16, 0, 0); } while (0)
#define PG8_LDA(dst, b, h) do { _Pragma("unroll") for (int m = 0; m < 4; ++m) _Pragma("unroll") for (int k = 0; k < 2; ++k) dst[m][k] = *(const PG8_LAS bf16x8*)(lds + PG8_SA(b, h) + aoff + m * 2048 + k * 1024); } while (0)
#define PG8_LDB(dst, b, h) do { _Pragma("unroll") for (int n = 0; n < 2; ++n) _Pragma("unroll") for (int k = 0; k < 2; ++k) dst[n][k] = *(const PG8_LAS bf16x8*)(lds + PG8_SB(b, h) + boff + n * 2048 + k * 1024); } while (0)
#define PG8_MMA(ai, bj, At, Bt) do { __builtin_amdgcn_s_setprio(1); _Pragma("unroll") for (int m = 0; m < 4; ++m) _Pragma("unroll") for (int n = 0; n < 2; ++n) _Pragma("unroll") for (int k = 0; k < 2; ++k) \
        acc[ai][bj][m][n] = __builtin_amdgcn_mfma_f32_16x16x32_bf16(Bt[n][k], At[m][k], acc[ai][bj][m][n], 0, 0, 0); __builtin_amdgcn_s_setprio(0); } while (0)
#define PG8_WAIT_V(n) asm volatile("s_waitcnt vmcnt(" #n ")" ::: "memory")
#define PG8_WAIT_L(n) asm volatile("s_waitcnt lgkmcnt(" #n ")" ::: "memory")
#define PG8_BAR __builtin_amdgcn_s_barrier()
#define PG8_SCHED __builtin_amdgcn_sched_barrier(0)
    Unit cur, nxt; int ui = 0;
    if (!S.next(0, cur)) return;
    f32x4 acc[2][2][4][2];
#pragma unroll
    for (int a = 0; a < 2; ++a)
#pragma unroll
        for (int b = 0; b < 2; ++b)
#pragma unroll
            for (int m = 0; m < 4; ++m)
#pragma unroll
                for (int n = 0; n < 2; ++n) acc[a][b][m][n] = (f32x4){0.f, 0.f, 0.f, 0.f};
    bf16x8 At[4][2], B0[2][2], B1[2][2];
    const char* cA = (const char*)g.A + (size_t)cur.pm * tstep; const char* cB = (const char*)g.Bt + (size_t)cur.pn * tstep;
    S.a_ready(cur);
    if constexpr (SP2) {
        PG8_STAGE(PG8_SB(0, 0), cB, voffB); PG8_STAGE(PG8_SB(0, 1), cB + hstep, voffB); PG8_STAGE(PG8_SA(0, 0), cA, voffA); PG8_STAGE(PG8_SA(0, 1), cA + hstep, voffA);
        if (wr == 1) PG8_BAR;
        PG8_WAIT_V(2); PG8_BAR;
        PG8_STAGE(PG8_SB(1, 0), cB + kstep, voffB); PG8_STAGE(PG8_SA(1, 0), cA + kstep, voffA); PG8_STAGE(PG8_SB(1, 1), cB + hstep + kstep, voffB);
        PG8_WAIT_V(6); PG8_BAR;
    } else {
        PG8_STAGE(PG8_SB(0, 0), cB, voffB); PG8_STAGE(PG8_SA(0, 0), cA, voffA); PG8_STAGE(PG8_SB(0, 1), cB + hstep, voffB); PG8_STAGE(PG8_SA(0, 1), cA + hstep, voffA);
        if (wr == 1) PG8_BAR;
        PG8_WAIT_V(4); PG8_BAR;
        PG8_STAGE(PG8_SB(1, 0), cB + kstep, voffB); PG8_STAGE(PG8_SA(1, 0), cA + kstep, voffA); PG8_STAGE(PG8_SB(1, 1), cB + hstep + kstep, voffB);
        PG8_WAIT_V(6); PG8_BAR;
    }
    for (;;) {
        const bool has_next = S.next(ui + 1, nxt);
        const char* nA = has_next ? (const char*)g.A + (size_t)nxt.pm * tstep : cA; const char* nB = has_next ? (const char*)g.Bt + (size_t)nxt.pn * tstep : cB;
        for (int t = 0; t < nt; t += 2) {
            const bool last = (t == nt - 2);
            const char* a1 = cA + (size_t)(t + 1) * kstep;
            const char* a2 = last ? nA : cA + (size_t)(t + 2) * kstep; const char* b2 = last ? nB : cB + (size_t)(t + 2) * kstep;
            const char* a3 = a2 + kstep; const char* b3 = b2 + kstep;
            if (last && has_next) S.a_ready(nxt);
            if constexpr (SP2) {
            PG8_LDB(B0, 0, 0); PG8_LDB(B1, 0, 1); PG8_SCHED; PG8_LDA(At, 0, 0); PG8_STAGE(PG8_SA(1, 1), a1 + hstep, voffA);
            PG8_WAIT_V(8); PG8_WAIT_L(0); PG8_BAR; PG8_MMA(0, 0, At, B0); PG8_MMA(0, 1, At, B1); PG8_BAR; PG8_SCHED;
            PG8_LDA(At, 0, 1); PG8_STAGE(PG8_SB(0, 0), b2, voffB); PG8_STAGE(PG8_SB(0, 1), b2 + hstep, voffB); PG8_STAGE(PG8_SA(0, 0), a2, voffA);
            PG8_WAIT_V(8); PG8_WAIT_L(0); PG8_BAR; PG8_MMA(1, 0, At, B0); PG8_MMA(1, 1, At, B1); PG8_BAR; PG8_SCHED;
            PG8_LDB(B0, 1, 0); PG8_LDB(B1, 1, 1); PG8_SCHED; PG8_LDA(At, 1, 0); PG8_STAGE(PG8_SA(0, 1), a2 + hstep, voffA);
            PG8_WAIT_V(8); PG8_WAIT_L(0); PG8_BAR; PG8_MMA(0, 0, At, B0); PG8_MMA(0, 1, At, B1); PG8_BAR; PG8_SCHED;
            PG8_LDA(At, 1, 1); PG8_STAGE(PG8_SB(1, 0), b3, voffB); PG8_STAGE(PG8_SB(1, 1), b3 + hstep, voffB); PG8_STAGE(PG8_SA(1, 0), a3, voffA);
            PG8_WAIT_V(8); PG8_WAIT_L(0); PG8_BAR; PG8_MMA(1, 0, At, B0); PG8_MMA(1, 1, At, B1); PG8_BAR; PG8_SCHED;
            } else {
            PG8_LDB(B0, 0, 0); PG8_SCHED; PG8_LDA(At, 0, 0); PG8_STAGE(PG8_SA(1, 1), a1 + hstep, voffA);
            PG8_WAIT_L(8); PG8_BAR; PG8_WAIT_L(0); PG8_MMA(0, 0, At, B0); PG8_BAR; PG8_SCHED;
            PG8_LDB(B1, 0, 1); PG8_STAGE(PG8_SB(0, 0), b2, voffB);
            PG8_BAR; PG8_WAIT_L(0); PG8_MMA(0, 1, At, B1); PG8_BAR;
            PG8_LDA(At, 0, 1); PG8_STAGE(PG8_SA(0, 0), a2, voffA);
            PG8_BAR; PG8_WAIT_L(0); PG8_MMA(1, 0, At, B0); PG8_BAR; PG8_SCHED;
            PG8_STAGE(PG8_SB(0, 1), b2 + hstep, voffB);
            PG8_WAIT_V(6); PG8_BAR; PG8_MMA(1, 1, At, B1); PG8_BAR;
            PG8_LDB(B0, 1, 0); PG8_SCHED; PG8_LDA(At, 1, 0); PG8_STAGE(PG8_SA(0, 1), a2 + hstep, voffA);
            PG8_WAIT_L(8); PG8_BAR; PG8_WAIT_L(0); PG8_MMA(0, 0, At, B0); PG8_BAR; PG8_SCHED;
            PG8_LDB(B1, 1, 1); PG8_STAGE(PG8_SB(1, 0), b3, voffB);
            PG8_BAR; PG8_WAIT_L(0); PG8_MMA(0, 1, At, B1); PG8_BAR;
            PG8_LDA(At, 1, 1); PG8_STAGE(PG8_SA(1, 0), a3, voffA);
            PG8_BAR; PG8_WAIT_L(0); PG8_MMA(1, 0, At, B0); PG8_BAR; PG8_SCHED;
            PG8_STAGE(PG8_SB(1, 1), b3 + hstep, voffB);
            PG8_WAIT_V(6); PG8_BAR; PG8_MMA(1, 1, At, B1); PG8_BAR;
            }
        }
        if constexpr (ALIGN_EPI) { if (wr == 0) PG8_BAR; }
        if constexpr (!Epi::AFTER_DRAIN) { int t2 = threadIdx.x; asm volatile("" : "+v"(t2)); E(acc, cur, wr, wc, t2 & 15, (t2 >> 4) & 3); S.done(cur); }
        if (!has_next) break;
#pragma unroll
        for (int a = 0; a < 2; ++a)
#pragma unroll
            for (int b = 0; b < 2; ++b)
#pragma unroll
                for (int m = 0; m < 4; ++m)
#pragma unroll
                    for (int n = 0; n < 2; ++n) acc[a][b][m][n] = (f32x4){0.f, 0.f, 0.f, 0.f};
        cur = nxt; cA = nA; cB = nB; ++ui;
        if constexpr (ALIGN_EPI) { if (wr == 1) PG8_BAR; }
    }
    PG8_WAIT_V(0);
    if constexpr (!ALIGN_EPI) { if (wr == 0) PG8_BAR; }
    PG8_BAR;
    if constexpr (Epi::AFTER_DRAIN) { E.fused(acc, cur, wr, wc, fr, fq, lds, wid, lane); S.done(cur); }
#undef PG8_SA
#undef PG8_SB
#undef PG8_STAGE
#undef PG8_LDA
#undef PG8_LDB
#undef PG8_MMA
#undef PG8_WAIT_V
#undef PG8_WAIT_L
#undef PG8_BAR
#undef PG8_SCHED
}
}
#define LAS __attribute__((address_space(3)))
#define GAS __attribute__((address_space(1)))
typedef unsigned short bf16;
typedef short bf16x8 __attribute__((ext_vector_type(8)));
typedef short s16x4 __attribute__((ext_vector_type(4)));
typedef float f32x4 __attribute__((ext_vector_type(4)));
typedef unsigned u32x4 __attribute__((ext_vector_type(4)));
typedef unsigned u32x2 __attribute__((ext_vector_type(2)));
constexpr int NT = 32768, DM = 1024, FF = 2816, SEQ = 2048, NB = 16, ZW = 3840, MEMR = 4096;
constexpr int ZQ = 0, ZK = 512, ZV = 1024, ZO = 1536, ZDQ = 2048, ZDC = 3072, ZIQ = 3200, ZIK = 3712, ZMI = 3776, ZMF = 3780, ZIW = 3784;
constexpr float EPS = 1e-6f, LOG2E = 1.4426950408889634f;
constexpr size_t MiB = 1u << 20;
constexpr size_t WS_PARTX = 0, WS_PARTA = 2 * MiB, WS_PARTB = 4 * MiB, WS_PARTC = 6 * MiB, WS_PARTD = 8 * MiB, WS_RSTDMEM = 10 * MiB, WS_WUV = 10 * MiB + 65536;
constexpr size_t WS_WGU1 = 16 * MiB, WS_WD1 = 27 * MiB, WS_WGU2 = 33 * MiB, WS_WD2 = 44 * MiB, WS_WIN = 50 * MiB, WS_WOUT = 58 * MiB, WS_WQ = 60 * MiB, WS_WK = 62 * MiB, WS_WV = 64 * MiB, WS_WO = 66 * MiB;
constexpr size_t WS_HB = 68 * MiB, WS_XB = 132 * MiB, WS_ACT = 196 * MiB, WS_Z = 132 * MiB, WS_QX = 132 * MiB, WS_XO = 196 * MiB, WS_Y = 372 * MiB;
constexpr size_t WS_CKV = 436 * MiB, WS_CKVT = 444 * MiB, WS_IKN = 452 * MiB, WS_MASK = 456 * MiB, WS_KX = 464 * MiB, WS_VTX = 472 * MiB, WS_MEMB = 480 * MiB, WS_END = 488 * MiB;
constexpr int LDS_BYTES = 147456;

struct Args {
    const float *x, *mem, *f1g, *f1wg, *f1wu, *f1wd, *mixg, *win, *convw, *convb, *ibias, *fbias, *headg, *kvg, *idxg, *wuv, *wout,
        *xag, *memg, *xwq, *xwkv, *xwo, *f2g, *f2wg, *f2wu, *f2wd, *fing;
    float* out; unsigned char* ws;
};

__device__ __forceinline__ unsigned f2bf(float f) { unsigned u = __builtin_bit_cast(unsigned, f); return (u + 0x7fffu + ((u >> 16) & 1u)) >> 16; }
typedef float f32x2_t __attribute__((ext_vector_type(2))); typedef __bf16 bf16x2_t __attribute__((ext_vector_type(2)));
__device__ __forceinline__ unsigned pk2(float lo, float hi) { f32x2_t v = {lo, hi}; bf16x2_t b = __builtin_convertvector(v, bf16x2_t); return __builtin_bit_cast(unsigned, b); }
__device__ __forceinline__ float bf2f(unsigned short v) { return __builtin_bit_cast(float, (unsigned)v << 16); }
__device__ __forceinline__ float bflo(unsigned w) { return __builtin_bit_cast(float, w << 16); }
__device__ __forceinline__ float bfhi(unsigned w) { return __builtin_bit_cast(float, w & 0xffff0000u); }
__device__ __forceinline__ float wave_sum(float v) {
#pragma unroll
    for (int o = 1; o < 64; o <<= 1) v += __shfl_xor(v, o);
    return v;
}
__device__ __forceinline__ f32x4 mfma16(bf16x8 a, bf16x8 b, f32x4 c) { return __builtin_amdgcn_mfma_f32_16x16x32_bf16(a, b, c, 0, 0, 0); }
__device__ __forceinline__ bf16x8 cat8(u32x2 lo, u32x2 hi) { u32x4 w; w.x = lo.x; w.y = lo.y; w.z = hi.x; w.w = hi.y; return __builtin_bit_cast(bf16x8, w); }
__device__ __forceinline__ bf16x8 pack8(f32x4 a, f32x4 b) { u32x4 w; w.x = pk2(a[0], a[1]); w.y = pk2(a[2], a[3]); w.z = pk2(b[0], b[1]); w.w = pk2(b[2], b[3]); return __builtin_bit_cast(bf16x8, w); }

#define LDPTR(i) ({ volatile LAS unsigned* p_ = (volatile LAS unsigned*)(lds + 131072 + 8 * (i)); const unsigned lo_ = __builtin_amdgcn_readfirstlane(p_[0]), hi_ = __builtin_amdgcn_readfirstlane(p_[1]); (const GAS float*)(((unsigned long long)hi_ << 32) | lo_); })
__device__ __forceinline__ void tr_block(const float* colp, float cs, const float* kg, int ldw, int K, bf16* WT, int d0, int k0, LAS float* scr, int lane) {
    float tv[32];
#pragma unroll
    for (int i = 0; i < 32; ++i) { const int kk = 2 * i + (lane >> 5); tv[i] = colp ? __builtin_nontemporal_load((const GAS float*)colp + (size_t)(k0 + kk) * ldw) : 0.f; }
#pragma unroll
    for (int i = 0; i < 32; ++i) { const int kk = 2 * i + (lane >> 5); scr[kk * 33 + (lane & 31)] = tv[i] * cs; }
    asm volatile("s_waitcnt lgkmcnt(0)" ::: "memory");
    const int c = lane & 7;
    f32x4 g0 = {1.f, 1.f, 1.f, 1.f}, g1 = {1.f, 1.f, 1.f, 1.f};
    if (kg) { g0 = *(const GAS f32x4*)(kg + k0 + 8 * c); g1 = *(const GAS f32x4*)(kg + k0 + 8 * c + 4); }
#pragma unroll
    for (int j = 0; j < 4; ++j) { const int n = (lane >> 3) + 8 * j; const LAS float* s = scr + (8 * c) * 33 + n;
        u32x4 o; o.x = pk2(s[0 * 33] * g0[0], s[1 * 33] * g0[1]); o.y = pk2(s[2 * 33] * g0[2], s[3 * 33] * g0[3]); o.z = pk2(s[4 * 33] * g1[0], s[5 * 33] * g1[1]); o.w = pk2(s[6 * 33] * g1[2], s[7 * 33] * g1[3]);
        *(GAS u32x4*)(WT + (size_t)(d0 + n) * K + k0 + 8 * c) = o; }
    asm volatile("s_waitcnt lgkmcnt(0)" ::: "memory");
}
__device__ __forceinline__ void p0_prologue(const Args& a, LAS unsigned char* lds, int vb, int G, int wave, int lane) {
    LAS float* scr = (LAS float*)(lds + wave * 16384);
    const int gw = vb * 8 + wave, NGW = G * 8;
    unsigned char* ws = a.ws;
    constexpr int I_GU = 16 * 176, I_D = 44 * 32, I_IN = 16 * 120, I_SQ = 16 * 32, I_UV = 32;
    constexpr int NITEMS = 2 * I_GU + 2 * I_D + I_IN + 5 * I_SQ + I_UV;
    for (int item = gw; item < NITEMS; item += NGW) {
        int it = item; const int l32 = lane & 31;
        if (it < 2 * I_GU) { const int l = it / I_GU; it %= I_GU; const int kb = it / 176, nb = it % 176, d = nb * 32 + l32, blk = d >> 8, w = d & 255;
            const float* wg = l ? a.f2wg : a.f1wg; const float* wu = l ? a.f2wu : a.f1wu;
            const float* src = (w < 128) ? wg + (blk * 128 + w) : wu + (blk * 128 + (w - 128));
            tr_block(src, 1.f, l ? a.f2g : a.f1g, FF, DM, (bf16*)(ws + (l ? WS_WGU2 : WS_WGU1)), nb * 32, kb * 64, scr, lane); continue; }
        it -= 2 * I_GU;
        if (it < 2 * I_D) { const int l = it / I_D; it %= I_D; const int kb = it / 32, nb = it % 32;
            tr_block((l ? a.f2wd : a.f1wd) + nb * 32 + l32, 1.f, nullptr, DM, FF, (bf16*)(ws + (l ? WS_WD2 : WS_WD1)), nb * 32, kb * 64, scr, lane); continue; }
        it -= 2 * I_D;
        if (it < I_IN) { const int kb = it / 120, nb = it % 120, d = nb * 32 + l32; int sc; float cs = 1.f;
            if (d < 1536) sc = d; else if (d < 2048) sc = d - 1536 + 1544;
            else if (d < 3072) { sc = d - 2048 + 2056; cs = a.kvg[(d - 2048) & 127] * (0.08838834764831845f * LOG2E); }
            else if (d < 3200) sc = d - 3072 + 3080;
            else if (d < 3712) { sc = d - 3200 + 3208; cs = a.idxg[(d - 3200) & 63]; }
            else if (d < 3776) sc = d - 3712 + 3720; else if (d < 3784) sc = d - 3776 + 1536; else if (d < 3792) sc = d; else sc = -1;
            tr_block(sc >= 0 ? a.win + sc : nullptr, cs, a.mixg, 3792, DM, (bf16*)(ws + WS_WIN), nb * 32, kb * 64, scr, lane); continue; }
        it -= I_IN;
        if (it < 5 * I_SQ) { const int which = it / I_SQ; it %= I_SQ; const int kb = it / 32, nb = it % 32, n = nb * 32 + l32;
            if (which == 0) tr_block(a.wout + n, 1.f, nullptr, DM, DM, (bf16*)(ws + WS_WOUT), nb * 32, kb * 64, scr, lane);
            else if (which == 1) tr_block(a.xwq + n, 0.0625f * LOG2E, a.xag, DM, DM, (bf16*)(ws + WS_WQ), nb * 32, kb * 64, scr, lane);
            else if (which == 2) tr_block(a.xwkv + n, 1.f, a.memg, 2 * DM, DM, (bf16*)(ws + WS_WK), nb * 32, kb * 64, scr, lane);
            else if (which == 3) tr_block(a.xwkv + DM + n, 1.f, a.memg, 2 * DM, DM, (bf16*)(ws + WS_WV), nb * 32, kb * 64, scr, lane);
            else tr_block(a.xwo + n, 1.f, nullptr, DM, DM, (bf16*)(ws + WS_WO), nb * 32, kb * 64, scr, lane);
            continue; }
        it -= 5 * I_SQ;
        { const int hh = it >> 2, kb = (it >> 1) & 1, nb = it & 1;
            tr_block(a.wuv + (size_t)hh * 128 * 64 + nb * 32 + l32, 1.f, a.kvg, 64, 128, (bf16*)(ws + WS_WUV), hh * 64 + nb * 32, kb * 64, scr, lane); }
    }
    for (int m0 = 2 * gw; m0 < NT + MEMR; m0 += 2 * NGW) {
        f32x4 v[2][4];
#pragma unroll
        for (int rr = 0; rr < 2; ++rr) { const int m = m0 + rr; const bool isx = m < NT; const int r = isx ? m : m - NT;
            const GAS f32x4* xr = (const GAS f32x4*)((isx ? a.x : a.mem) + (size_t)r * DM) + lane;
#pragma unroll
            for (int j = 0; j < 4; ++j) v[rr][j] = __builtin_nontemporal_load(&xr[64 * j]); }
#pragma unroll
        for (int rr = 0; rr < 2; ++rr) { const int m = m0 + rr; const bool isx = m < NT; const int r = isx ? m : m - NT; float s = 0.f;
#pragma unroll
            for (int j = 0; j < 4; ++j) s += (v[rr][j][0] * v[rr][j][0] + v[rr][j][1] * v[rr][j][1]) + (v[rr][j][2] * v[rr][j][2] + v[rr][j][3] * v[rr][j][3]);
            s = wave_sum(s);
            GAS u32x2* o8 = (GAS u32x2*)((GAS bf16*)(ws + (isx ? WS_XB : WS_MEMB)) + (size_t)r * DM) + lane;
#pragma unroll
            for (int j = 0; j < 4; ++j) { u32x2 w; w.x = pk2(v[rr][j][0], v[rr][j][1]); w.y = pk2(v[rr][j][2], v[rr][j][3]); o8[64 * j] = w; }
            if (isx) { if (lane < 16) ((GAS float*)(ws + WS_PARTX))[(size_t)r * 16 + lane] = lane == 0 ? s : 0.f; }
            else if (lane == 0) ((GAS float*)(ws + WS_RSTDMEM))[r] = rsqrtf(s * (1.f / 1024.f) + EPS); }
    }
}

__device__ __forceinline__ void prep_unit(const Args& a, LAS unsigned char* lds, int b, int kt, int tid) {
    const GAS bf16* z = (const GAS bf16*)(a.ws + WS_Z);
    LAS bf16* tT = (LAS bf16*)lds;
    const int key = tid >> 3, ch = tid & 7; const size_t row = (size_t)b * SEQ + kt * 64 + key;
    const u32x4 d0 = *(const GAS u32x4*)(z + row * ZW + ZDC + 16 * ch), d1 = *(const GAS u32x4*)(z + row * ZW + ZDC + 16 * ch + 8);
    const u32x4 k0 = *(const GAS u32x4*)(z + row * ZW + ZIK + 8 * ch);
    float v[16]; float ss = 0.f;
#pragma unroll
    for (int i = 0; i < 4; ++i) { v[2 * i] = bflo(d0[i]); v[2 * i + 1] = bfhi(d0[i]); v[8 + 2 * i] = bflo(d1[i]); v[8 + 2 * i + 1] = bfhi(d1[i]); }
#pragma unroll
    for (int i = 0; i < 16; ++i) ss += v[i] * v[i];
    ss += __shfl_xor(ss, 1); ss += __shfl_xor(ss, 2); ss += __shfl_xor(ss, 4);
    const float r = rsqrtf(ss * (1.f / 128.f) + EPS);
    unsigned short o[16];
    u32x4 w0, w1;
#pragma unroll
    for (int i = 0; i < 4; ++i) { w0[i] = pk2(v[2 * i] * r, v[2 * i + 1] * r); w1[i] = pk2(v[8 + 2 * i] * r, v[8 + 2 * i + 1] * r);
        o[2 * i] = (unsigned short)(w0[i] & 0xffffu); o[2 * i + 1] = (unsigned short)(w0[i] >> 16); o[8 + 2 * i] = (unsigned short)(w1[i] & 0xffffu); o[8 + 2 * i + 1] = (unsigned short)(w1[i] >> 16); }
    GAS bf16* ckv = (GAS bf16*)(a.ws + WS_CKV);
    *(GAS u32x4*)(ckv + row * 128 + 16 * ch) = w0; *(GAS u32x4*)(ckv + row * 128 + 16 * ch + 8) = w1;
#pragma unroll
    for (int i = 0; i < 16; ++i) tT[(16 * ch + i) * 72 + key] = o[i];
    float kv[8]; float s2 = 0.f;
#pragma unroll
    for (int i = 0; i < 4; ++i) { kv[2 * i] = bflo(k0[i]); kv[2 * i + 1] = bfhi(k0[i]); }
#pragma unroll
    for (int i = 0; i < 8; ++i) s2 += kv[i] * kv[i];
    s2 += __shfl_xor(s2, 1); s2 += __shfl_xor(s2, 2); s2 += __shfl_xor(s2, 4);
    const float r2 = rsqrtf(s2 * (1.f / 64.f) + EPS);
    u32x4 wk;
#pragma unroll
    for (int i = 0; i < 4; ++i) wk[i] = pk2(kv[2 * i] * r2, kv[2 * i + 1] * r2);
    *(GAS u32x4*)((GAS bf16*)(a.ws + WS_IKN) + row * 64 + 8 * ch) = wk;
    __syncthreads();
    const int c = tid >> 2, q4 = tid & 3;
    const u32x4 t0 = *(const LAS u32x4*)(tT + c * 72 + 16 * q4), t1 = *(const LAS u32x4*)(tT + c * 72 + 16 * q4 + 8);
    GAS bf16* dst = (GAS bf16*)(a.ws + WS_CKVT) + ((size_t)b * 128 + c) * SEQ + kt * 64 + 16 * q4;
    *(GAS u32x4*)dst = t0; *(GAS u32x4*)(dst + 8) = t1;
    __syncthreads();
}
__device__ __forceinline__ void indexer_unit(const Args& a, LAS unsigned char* lds, LAS unsigned long long* maskl, int b, int qblk, int wave, int lane) {
    LAS float* sc = (LAS float*)lds;
    const GAS bf16* z = (const GAS bf16*)(a.ws + WS_Z); const GAS bf16* ikn = (const GAS bf16*)(a.ws + WS_IKN);
    const int fr = lane & 15, fq = lane >> 4, t0 = qblk * 16; const size_t rowb = (size_t)b * SEQ;
    bf16x8 af[8][2]; float wv[8][4];
#pragma unroll
    for (int rt = 0; rt < 8; ++rt) {
        const GAS bf16* p = z + (rowb + t0 + 2 * rt + (fr >> 3)) * ZW + ZIQ + (fr & 7) * 64 + 8 * fq;
        af[rt][0] = __builtin_nontemporal_load((const GAS bf16x8*)p); af[rt][1] = __builtin_nontemporal_load((const GAS bf16x8*)(p + 32));
        const u32x2 w = *(const GAS u32x2*)(z + (rowb + t0 + 2 * rt + (fq >> 1)) * ZW + ZIW + 4 * (fq & 1));
        wv[rt][0] = bflo(w.x); wv[rt][1] = bfhi(w.x); wv[rt][2] = bflo(w.y); wv[rt][3] = bfhi(w.y);
    }
    const int nkt = qblk + 1;
    bf16x8 nb0, nb1;
    { const int k0 = wave < nkt ? wave : 0; const GAS bf16* p = ikn + (rowb + 16 * k0 + fr) * 64 + 8 * fq; nb0 = *(const GAS bf16x8*)p; nb1 = *(const GAS bf16x8*)(p + 32); }
    for (int kt = wave; kt < nkt; kt += 8) {
        const int key = 16 * kt + fr;
        const bf16x8 b0 = nb0, b1 = nb1;
        { const int k2 = kt + 8 < nkt ? kt + 8 : kt; const GAS bf16* p = ikn + (rowb + 16 * k2 + fr) * 64 + 8 * fq; nb0 = *(const GAS bf16x8*)p; nb1 = *(const GAS bf16x8*)(p + 32); }
#pragma unroll
        for (int rt = 0; rt < 8; ++rt) {
            f32x4 acc = {0.f, 0.f, 0.f, 0.f};
            acc = mfma16(af[rt][0], b0, acc); acc = mfma16(af[rt][1], b1, acc);
            float part = wv[rt][0] * fmaxf(acc[0], 0.f) + wv[rt][1] * fmaxf(acc[1], 0.f) + wv[rt][2] * fmaxf(acc[2], 0.f) + wv[rt][3] * fmaxf(acc[3], 0.f);
            part += __shfl_xor(part, 16); part += 0.f;
            if ((fq & 1) == 0) sc[(2 * rt + (fq >> 1)) * 2048 + key] = part;
        }
    }
    __syncthreads();
#pragma unroll 1
    for (int qq = 0; qq < 2; ++qq) {
        const int q = 2 * wave + qq, t = t0 + q, n = t + 1;
        unsigned long long myword = 0ull;
        if (n <= 256) {
            const int lo = 64 * lane;
            myword = (n >= lo + 64) ? ~0ull : (n > lo ? ((1ull << (n - lo)) - 1ull) : 0ull);
        } else {
            const int nr = __builtin_amdgcn_readfirstlane((n + 63) >> 6);
            unsigned u[32];
#pragma unroll
            for (int r = 0; r < 32; ++r) u[r] = 0u;
#pragma unroll
            for (int g = 0; g < 8; ++g) if (4 * g < nr) {
#pragma unroll
                for (int k4 = 0; k4 < 4; ++k4) { const int r = 4 * g + k4; const int idx = 64 * r + lane; const unsigned bits = __builtin_bit_cast(unsigned, sc[q * 2048 + idx]);
                    const unsigned k = bits ^ (((unsigned)((int)bits >> 31)) | 0x80000000u); u[r] = idx < n ? k : 0u; } }
            unsigned T = 0u; bool exact = false; const int ng = (nr + 3) >> 2;
#pragma unroll 1
            for (int bit = 31; bit >= 0; --bit) {
                const unsigned cand = T | (1u << bit); int cnt = 0;
#define TK_GRP(g) { const int c0 = __popcll(__ballot(u[4 * (g)] >= cand)), c1 = __popcll(__ballot(u[4 * (g) + 1] >= cand)), c2 = __popcll(__ballot(u[4 * (g) + 2] >= cand)), c3 = __popcll(__ballot(u[4 * (g) + 3] >= cand)); cnt += (c0 + c1) + (c2 + c3); }
                switch (ng) {
                    case 8: TK_GRP(7) [[fallthrough]];
                    case 7: TK_GRP(6) [[fallthrough]];
                    case 6: TK_GRP(5) [[fallthrough]];
                    case 5: TK_GRP(4) [[fallthrough]];
                    case 4: TK_GRP(3) [[fallthrough]];
                    case 3: TK_GRP(2) [[fallthrough]];
                    case 2: TK_GRP(1) [[fallthrough]];
                    default: TK_GRP(0)
                }
#undef TK_GRP
                if (cnt >= 256) { T = cand; if (cnt == 256) { exact = true; break; } }
            }
            int need = 0; const unsigned long long lt = (1ull << lane) - 1ull;
            if (!exact) {
                int cl = 0;
#pragma unroll
                for (int r = 0; r < 32; ++r) cl += (u[r] > T) ? 1 : 0;
                int ngt = 0;
#pragma unroll
                for (int bb = 0; bb < 6; ++bb) ngt += __popcll(__ballot((cl >> bb) & 1)) << bb;
                need = 256 - ngt;
            }
#pragma unroll
            for (int g = 0; g < 8; ++g) if (4 * g < nr) {
#pragma unroll
                for (int k = 0; k < 4; ++k) { const int r = 4 * g + k;
                    unsigned ur = u[r]; asm volatile("" : "+v"(ur), "+v"(myword), "+s"(need));
                    unsigned long long m;
                    if (exact) m = __ballot(ur >= T);
                    else { const unsigned long long eq = __ballot(ur == T), gt = __ballot(ur > T);
                        const bool pick = (ur == T) && (__popcll(eq & lt) < need);
                        m = gt | __ballot(pick); need -= __popcll(eq); if (need < 0) need = 0; }
                    if (lane == r) myword = m; } }
        }
        if (lane < 32) maskl[q * 32 + lane] = myword;
    }
    __syncthreads();
}

#define LDS_BARRIER() do { asm volatile("s_waitcnt lgkmcnt(0)" ::: "memory"); __builtin_amdgcn_s_barrier(); asm volatile("" ::: "memory"); } while (0)
__device__ __forceinline__ float rdlane(float v, int l) { return __builtin_bit_cast(float, __builtin_amdgcn_readlane(__builtin_bit_cast(int, v), l)); }
__device__ __forceinline__ float scan_add(float v, int lane) {
#pragma unroll
    for (int o = 1; o < 64; o <<= 1) { const float t = __shfl_up(v, o); if (lane >= o) v += t; }
    return v;
}
__device__ __forceinline__ float scan_max(float v, int lane) {
#pragma unroll
    for (int o = 1; o < 64; o <<= 1) { const float t = __shfl_up(v, o); if (lane >= o) v = fmaxf(v, t); }
    return v;
}
__device__ __forceinline__ void mlstm_unit(const Args& a, LAS unsigned char* lds, int b, int h, int tid_in, int wave, int lane_in) {
    int tid = tid_in; asm volatile("" : "+v"(tid)); const int lane0 = tid & 63;
    constexpr int QS = 136, TS = 72, NS = 132;
    LAS bf16* q_s = (LAS bf16*)lds;
    LAS bf16* k_s = (LAS bf16*)(lds + 17408);
    LAS float* numS = (LAS float*)lds;
    LAS bf16* kTw = (LAS bf16*)(lds + 34816);
    LAS bf16* vT = (LAS bf16*)(lds + 53248);
    LAS bf16* P_s = (LAS bf16*)(lds + 73984);
    LAS bf16* C_s = (LAS bf16*)(lds + 83200);
    LAS float* gate = (LAS float*)(lds + 122368);
    LAS float* cw_s = (LAS float*)(lds + 124416);
    const GAS bf16* z = (const GAS bf16*)(a.ws + WS_Z); GAS bf16* Y = (GAS bf16*)(a.ws + WS_Y);
    const size_t rowb = (size_t)b * SEQ;
    for (int i = tid; i < 144 * 136 / 2; i += 512) ((LAS unsigned*)C_s)[i] = 0u;
    for (int i = tid; i < 16 * 72; i += 512) vT[128 * 72 + i] = (i < 64) ? (bf16)0x3f80 : (bf16)0;
    LAS float* hg_s = (LAS float*)(lds + 129536);
    float ib, fb;
    { const GAS float* convw = LDPTR(1); const GAS float* convb = LDPTR(2); const GAS float* hgp = LDPTR(5);
      for (int i = tid; i < 5 * 256; i += 512) { const int j = i >> 8, c = i & 255, col = (c < 128 ? h * 128 + c : 512 + h * 128 + (c - 128)); cw_s[i] = j < 4 ? convw[j * 1024 + col] : convb[col]; }
      if (tid < 128) hg_s[tid] = hgp[h * 128 + tid];
      ib = LDPTR(3)[h]; fb = LDPTR(4)[h]; }
    f32x4 Creg[9];
#pragma unroll
    for (int e = 0; e < 9; ++e) Creg[e] = (f32x4){0.f, 0.f, 0.f, 0.f};
    float mstate = 0.f;
    const int sel = tid >> 8, cgp = tid & 15, rg = (tid >> 4) & 15;
    const int colbase = (sel ? ZK : ZQ) + h * 128 + 8 * cgp;
    u32x4 raw[7], rawv[4]; unsigned short gmi, gmf; u32x4 ow2[2];
    const GAS char* zb = (const GAS char*)z;
    const unsigned vo_qk = (unsigned)((4 * rg) * ZW + colbase) * 2u, vo_v = (unsigned)((4 * rg) * ZW + ZV + h * 128 + 8 * cgp) * 2u;
    const unsigned vo_y = (unsigned)((8 * wave + (lane0 >> 3)) * DM + h * 128 + 16 * (lane0 & 7)) * 2u;
    const unsigned vo_g = (unsigned)(lane0 * ZW + ZMI + h) * 2u, vo_o = (unsigned)((8 * wave + (lane0 >> 3)) * ZW + ZO + h * 128 + 16 * (lane0 & 7)) * 2u;
#define ML_LOAD(cc) do { const int t0_ = 64 * (cc); const GAS char* zc_ = zb + (size_t)(rowb + t0_) * (ZW * 2); const GAS char* zc3_ = zc_ - 3 * (ZW * 2); \
        _Pragma("unroll") for (int jj = 0; jj < 7; ++jj) { const int tt = t0_ + 4 * rg - 3 + jj; raw[jj] = (u32x4){0u, 0u, 0u, 0u}; if (tt >= 0) raw[jj] = __builtin_nontemporal_load((const GAS u32x4*)(zc3_ + (size_t)(vo_qk + (unsigned)(jj * ZW * 2)))); } \
        if (sel == 0) { _Pragma("unroll") for (int i = 0; i < 4; ++i) rawv[i] = __builtin_nontemporal_load((const GAS u32x4*)(zc_ + (size_t)(vo_v + (unsigned)(i * ZW * 2)))); } \
        gmi = *(const GAS unsigned short*)(zc_ + (size_t)vo_g); gmf = *(const GAS unsigned short*)(zc_ + (size_t)(vo_g + 8u)); } while (0)
    LAS float* wgx = (LAS float*)(lds + 131072 + 256);
    ML_LOAD(0);
    float bc, av, pm;
    { const float mi = bf2f(gmi) + ib, mf = bf2f(gmf) + fb; const float lf = fminf(mf, 0.f) - __logf(1.f + __expf(-fabsf(mf)));
      bc = scan_add(lf, lane0); av = mi - bc; pm = scan_max(av, lane0); }
    __syncthreads();
#pragma unroll 1
    for (int c = 0; c < 32; ++c) {
        const int t0 = 64 * c, par = c & 1;
        int lane_i = lane0; asm volatile("" : "+v"(lane_i));
        const int lane = lane_i, fr = lane & 15, fq = lane >> 4;
        const float Mj = fmaxf(mstate, pm), M63 = rdlane(Mj, 63), bL = rdlane(bc, 63);
        const float wg = __expf(av - M63);
        if (wave == 0) { gate[par * 192 + lane] = Mj; gate[par * 192 + 64 + lane] = bc; gate[par * 192 + 128 + lane] = av; }
        wgx[wave * 64 + lane] = wg;
        asm volatile("s_waitcnt lgkmcnt(0)" ::: "memory");
        const f32x4 wgq = *(const LAS f32x4*)(wgx + wave * 64 + 4 * rg);
        const float wgv[4] = {wgq[0], wgq[1], wgq[2], wgq[3]};
        {
            float y[4][8];
#pragma unroll
            for (int e = 0; e < 8; ++e) {
                const int cc = sel * 128 + 8 * cgp + e;
                const float w0 = cw_s[cc], w1 = cw_s[256 + cc], w2 = cw_s[512 + cc], w3 = cw_s[768 + cc], bb = cw_s[1024 + cc];
                float xr[7];
#pragma unroll
                for (int jj = 0; jj < 7; ++jj) { const unsigned w = raw[jj][e >> 1]; xr[jj] = (e & 1) ? bfhi(w) : bflo(w); }
#pragma unroll
                for (int i = 0; i < 4; ++i) { const float xx = bb + w0 * xr[i] + w1 * xr[i + 1] + w2 * xr[i + 2] + w3 * xr[i + 3];
                    float s = xx * __builtin_amdgcn_rcpf(1.f + __expf(-xx)); if (sel) s *= 0.08838834764831845f; y[i][e] = s; }
            }
            LAS bf16* dst = sel ? k_s : q_s;
#pragma unroll
            for (int i = 0; i < 4; ++i) { u32x4 w; w.x = pk2(y[i][0], y[i][1]); w.y = pk2(y[i][2], y[i][3]); w.z = pk2(y[i][4], y[i][5]); w.w = pk2(y[i][6], y[i][7]);
                *(LAS u32x4*)(dst + (4 * rg + i) * QS + 8 * cgp) = w; }
            if (sel) {
#pragma unroll
                for (int e = 0; e < 8; ++e) { u32x2 w; w.x = pk2(y[0][e] * wgv[0], y[1][e] * wgv[1]); w.y = pk2(y[2][e] * wgv[2], y[3][e] * wgv[3]); *(LAS u32x2*)(kTw + (8 * cgp + e) * TS + 8 * ((rg >> 1) ^ ((cgp >> 1) & 7)) + 4 * (rg & 1)) = w; }
            } else {
#pragma unroll
                for (int e = 0; e < 8; ++e) { unsigned short v0 = (e & 1) ? (unsigned short)(rawv[0][e >> 1] >> 16) : (unsigned short)(rawv[0][e >> 1] & 0xffffu);
                    unsigned short v1 = (e & 1) ? (unsigned short)(rawv[1][e >> 1] >> 16) : (unsigned short)(rawv[1][e >> 1] & 0xffffu);
                    unsigned short v2 = (e & 1) ? (unsigned short)(rawv[2][e >> 1] >> 16) : (unsigned short)(rawv[2][e >> 1] & 0xffffu);
                    unsigned short v3 = (e & 1) ? (unsigned short)(rawv[3][e >> 1] >> 16) : (unsigned short)(rawv[3][e >> 1] & 0xffffu);
                    u32x2 w; w.x = v0 | ((unsigned)v1 << 16); w.y = v2 | ((unsigned)v3 << 16); *(LAS u32x2*)(vT + (8 * cgp + e) * TS + 8 * ((rg >> 1) ^ ((cgp >> 1) & 7)) + 4 * (rg & 1)) = w; }
            }
        }
        if (c + 1 < 32) ML_LOAD(c + 1);
        { const GAS char* zc_ = zb + (size_t)(rowb + t0) * (ZW * 2); ow2[0] = __builtin_nontemporal_load((const GAS u32x4*)(zc_ + (size_t)vo_o)); ow2[1] = __builtin_nontemporal_load((const GAS u32x4*)(zc_ + (size_t)(vo_o + 16u))); }
        LDS_BARRIER();
        {
            const int jt = wave >> 1;
#pragma unroll
            for (int s2 = 0; s2 < 2; ++s2) {
                const int st = 2 * (wave & 1) + s2;
                f32x4 acc = {0.f, 0.f, 0.f, 0.f};
                if (st <= jt) {
#pragma unroll
                    for (int kk = 0; kk < 4; ++kk) acc = mfma16(*(const LAS bf16x8*)(q_s + (16 * jt + fr) * QS + 32 * kk + 8 * fq), *(const LAS bf16x8*)(k_s + (16 * st + fr) * QS + 32 * kk + 8 * fq), acc);
                }
                const int s = 16 * st + fr; const float as = gate[par * 192 + 128 + s];
                float pv4[4];
#pragma unroll
                for (int i = 0; i < 4; ++i) { const int j = 16 * jt + 4 * fq + i; pv4[i] = (s <= j) ? acc[i] * __expf(as - gate[par * 192 + j]) : 0.f; }
                { const unsigned w0 = pk2(pv4[0], pv4[1]), w1 = pk2(pv4[2], pv4[3]); const int j0 = 16 * jt + 4 * fq;
                  P_s[(j0 + 0) * TS + s] = (bf16)(w0 & 0xffffu); P_s[(j0 + 1) * TS + s] = (bf16)(w0 >> 16); P_s[(j0 + 2) * TS + s] = (bf16)(w1 & 0xffffu); P_s[(j0 + 3) * TS + s] = (bf16)(w1 >> 16); }
            }
        }
        const int jt2 = wave & 3, etb = 4 * (wave >> 2);
        f32x4 hacc[5];
#pragma unroll
        for (int x = 0; x < 5; ++x) {
            hacc[x] = (f32x4){0.f, 0.f, 0.f, 0.f};
            const int et = x < 4 ? etb + x : 8;
            if (x & 1) asm volatile("" ::: "memory");
            if (x < 4 || wave < 4) {
#pragma unroll
                for (int kk = 0; kk < 4; ++kk) hacc[x] = mfma16(*(const LAS bf16x8*)(q_s + (16 * jt2 + fr) * QS + 32 * kk + 8 * fq), *(const LAS bf16x8*)(C_s + (16 * et + fr) * QS + 32 * kk + 8 * fq), hacc[x]);
            }
        }
        {
            float sc4[4];
#pragma unroll
            for (int i = 0; i < 4; ++i) sc4[i] = __expf(mstate - gate[par * 192 + 16 * jt2 + 4 * fq + i]);
#pragma unroll
            for (int x = 0; x < 5; ++x)
#pragma unroll
                for (int i = 0; i < 4; ++i) hacc[x][i] *= sc4[i];
        }
        LDS_BARRIER();
#pragma unroll
        for (int x = 0; x < 5; ++x) {
            const int et = x < 4 ? etb + x : 8;
            if (x & 1) asm volatile("" ::: "memory");
            if (x < 4 || wave < 4) {
#pragma unroll
                for (int kk = 0; kk < 2; ++kk) hacc[x] = mfma16(*(const LAS bf16x8*)(P_s + (16 * jt2 + fr) * TS + 32 * kk + 8 * fq), *(const LAS bf16x8*)(vT + (16 * et + fr) * TS + 8 * ((4 * kk + fq) ^ (et & 7))), hacc[x]);
#pragma unroll
                for (int i = 0; i < 4; ++i) { const int e = 16 * et + fr; if (e < 129) numS[(16 * jt2 + 4 * fq + i) * NS + e] = hacc[x][i]; }
            }
        }
        {
            const float dec = __expf(mstate - M63);
#pragma unroll
            for (int et = 0; et < 9; ++et) {
                if ((et & 1) == 0) asm volatile("" ::: "memory");
                Creg[et] = Creg[et] * dec;
#pragma unroll
                for (int kk = 0; kk < 2; ++kk) Creg[et] = mfma16(*(const LAS bf16x8*)(vT + (16 * et + fr) * TS + 8 * ((4 * kk + fq) ^ (et & 7))), *(const LAS bf16x8*)(kTw + (16 * wave + fr) * TS + 8 * ((4 * kk + fq) ^ (wave & 7))), Creg[et]);
                { const unsigned w0 = pk2(Creg[et][0], Creg[et][1]), w1 = pk2(Creg[et][2], Creg[et][3]); const int e0 = 16 * et + 4 * fq, dcol = 16 * wave + fr;
                  C_s[(e0 + 0) * QS + dcol] = (bf16)(w0 & 0xffffu); C_s[(e0 + 1) * QS + dcol] = (bf16)(w0 >> 16); C_s[(e0 + 2) * QS + dcol] = (bf16)(w1 & 0xffffu); C_s[(e0 + 3) * QS + dcol] = (bf16)(w1 >> 16); }
            }
        }
        LDS_BARRIER();
        {
            const int jr = lane >> 3, ec = lane & 7, j = 8 * wave + jr;
            f32x4 nv[4], gv[4];
#pragma unroll
            for (int k = 0; k < 4; ++k) { nv[k] = *(const LAS f32x4*)(numS + j * NS + 16 * ec + 4 * k); gv[k] = *(const LAS f32x4*)(hg_s + 16 * ec + 4 * k); }
            const float den = numS[j * NS + 128];
            const float dn = fmaxf(fabsf(den), __expf(-(gate[par * 192 + 64 + j] + gate[par * 192 + j])));
            const float idn = __builtin_amdgcn_rcpf(dn); float ss = 0.f;
#pragma unroll
            for (int k = 0; k < 4; ++k) { nv[k] = nv[k] * idn; ss += (nv[k][0] * nv[k][0] + nv[k][1] * nv[k][1]) + (nv[k][2] * nv[k][2] + nv[k][3] * nv[k][3]); }
            ss += __shfl_xor(ss, 1); ss += __shfl_xor(ss, 2); ss += __shfl_xor(ss, 4);
            const float rs = rsqrtf(ss * (1.f / 128.f) + EPS);
            u32x4 yo[2];
#pragma unroll
            for (int k = 0; k < 4; ++k) {
                const unsigned w0 = ow2[k >> 1][2 * (k & 1)], w1 = ow2[k >> 1][2 * (k & 1) + 1];
                const float o0 = bflo(w0), o1 = bfhi(w0), o2 = bflo(w1), o3 = bfhi(w1);
                const float y0 = nv[k][0] * rs * gv[k][0] * __builtin_amdgcn_rcpf(1.f + __expf(-o0)), y1 = nv[k][1] * rs * gv[k][1] * __builtin_amdgcn_rcpf(1.f + __expf(-o1));
                const float y2 = nv[k][2] * rs * gv[k][2] * __builtin_amdgcn_rcpf(1.f + __expf(-o2)), y3 = nv[k][3] * rs * gv[k][3] * __builtin_amdgcn_rcpf(1.f + __expf(-o3));
                yo[k >> 1][2 * (k & 1)] = pk2(y0, y1); yo[k >> 1][2 * (k & 1) + 1] = pk2(y2, y3);
            }
            GAS char* yp = (GAS char*)Y + (size_t)(rowb + t0) * (DM * 2) + (size_t)vo_y;
            *(GAS u32x4*)yp = yo[0]; *(GAS u32x4*)(yp + 16) = yo[1];
        }
        mstate = bL + M63;
        if (c + 1 < 32) {
            const float mi = bf2f(gmi) + ib, mf = bf2f(gmf) + fb; const float lf = fminf(mf, 0.f) - __logf(1.f + __expf(-fabsf(mf)));
            bc = scan_add(lf, lane); av = mi - bc; pm = scan_max(av, lane); }
        LDS_BARRIER();
    }
}
typedef float f32x16 __attribute__((ext_vector_type(16)));
__device__ __forceinline__ f32x16 mfma32(bf16x8 a, bf16x8 b, f32x16 c) { return __builtin_amdgcn_mfma_f32_32x32x16_bf16(a, b, c, 0, 0, 0); }
__device__ __forceinline__ void dsa_unit32(const Args& a, LAS unsigned char* lds, const LAS unsigned long long* maskl, int b, int qb, int tid, int wave, int lane) {
    constexpr int KS = 136, VS = 76, KBYTES = 64 * KS * 2, STG = KBYTES + 128 * VS * 2;
    const GAS bf16* z = (const GAS bf16*)(a.ws + WS_Z); const GAS bf16* ckv = (const GAS bf16*)(a.ws + WS_CKV); const GAS bf16* ckvT = (const GAS bf16*)(a.ws + WS_CKVT);
    const GAS bf16* wuv = (const GAS bf16*)(a.ws + WS_WUV); GAS bf16* Y = (GAS bf16*)(a.ws + WS_Y);
    const int l31 = lane & 31, hi = lane >> 5, t0 = qb * 32, h = wave; const size_t rowb = (size_t)b * SEQ;
    bf16x8 qf[8]; float qs = 0.f;
#pragma unroll
    for (int ks = 0; ks < 8; ++ks) { const u32x4 w = __builtin_nontemporal_load((const GAS u32x4*)(z + (rowb + t0 + l31) * ZW + ZDQ + h * 128 + 16 * ks + 8 * hi)); qf[ks] = __builtin_bit_cast(bf16x8, w);
#pragma unroll
        for (int i = 0; i < 4; ++i) { const float x0 = bflo(w[i]), x1 = bfhi(w[i]); qs += x0 * x0 + x1 * x1; } }
    qs += __shfl_xor(qs, 32);
    const float negB = -1.01f * 11.313708498984761f * sqrtf(qs);
    const int nkt = (t0 + 32 + 63) >> 6;
    f32x16 O[4];
#pragma unroll
    for (int ct = 0; ct < 4; ++ct)
#pragma unroll
        for (int i = 0; i < 16; ++i) O[ct][i] = 0.f;
    float l = 0.f;
    u32x4 rk0[2], rv0[2], rk1[2], rv1[2];
    const unsigned vok0 = (unsigned)((tid >> 4) * 128 + 8 * (tid & 15)) * 2u, vok1 = vok0 + 32u * 128u * 2u;
    const unsigned vov0 = (unsigned)((tid >> 3) * SEQ + 8 * (tid & 7)) * 2u, vov1 = vov0 + 64u * (unsigned)SEQ * 2u;
    const GAS char* ckb = (const GAS char*)ckv + (size_t)rowb * 256; const GAS char* cvb = (const GAS char*)ckvT + (size_t)b * 128 * SEQ * 2;
#define DSA_GLOAD(kt, RK, RV) do { const GAS char* kb_ = ckb + (size_t)(kt) * (64 * 256); const GAS char* vb_ = cvb + (size_t)(kt) * 128; \
        RK[0] = *(const GAS u32x4*)(kb_ + (size_t)vok0); RK[1] = *(const GAS u32x4*)(kb_ + (size_t)vok1); \
        RV[0] = *(const GAS u32x4*)(vb_ + (size_t)vov0); RV[1] = *(const GAS u32x4*)(vb_ + (size_t)vov1); } while (0)
#define DSA_LSTORE(buf, RK, RV) do { LAS bf16* Ks_ = (LAS bf16*)(lds + (buf) * STG); LAS bf16* Vs_ = (LAS bf16*)(lds + (buf) * STG + KBYTES); \
        _Pragma("unroll") for (int i = 0; i < 2; ++i) { const int id = tid + 512 * i; *(LAS u32x4*)(Ks_ + (id >> 4) * KS + 8 * (id & 15)) = RK[i]; \
            u32x2 lo_, hh_; lo_.x = RV[i].x; lo_.y = RV[i].y; hh_.x = RV[i].z; hh_.y = RV[i].w; \
            *(LAS u32x2*)(Vs_ + (id >> 3) * VS + 8 * (id & 7)) = lo_; *(LAS u32x2*)(Vs_ + (id >> 3) * VS + 8 * (id & 7) + 4) = hh_; } } while (0)
    auto compute = [&](int buf, int kt) {
        const unsigned long long mw = maskl[l31 * 32 + kt];
        const LAS bf16* Ks = (const LAS bf16*)(lds + buf * STG); const LAS bf16* Vs = (const LAS bf16*)(lds + buf * STG + KBYTES);
        f32x16 S2[2];
#pragma unroll
        for (int kh = 0; kh < 2; ++kh) {
#pragma unroll
            for (int i = 0; i < 16; ++i) S2[kh][i] = negB;
#pragma unroll
            for (int ks = 0; ks < 8; ++ks) S2[kh] = mfma32(*(const LAS bf16x8*)(Ks + (32 * kh + l31) * KS + 16 * ks + 8 * hi), qf[ks], S2[kh]);
        }
#pragma unroll
        for (int kh = 0; kh < 2; ++kh) {
            const unsigned mh = (unsigned)(mw >> (32 * kh + 4 * hi));
            float p[16];
#pragma unroll
            for (int i = 0; i < 16; ++i) { const float e = __builtin_amdgcn_exp2f(S2[kh][i]);
                const int keep = __builtin_amdgcn_sbfe((int)mh, 8 * (i >> 2) + (i & 3), 1);
                p[i] = __builtin_bit_cast(float, __builtin_bit_cast(int, e) & keep); l += p[i]; }
            u32x4 w0, w1;
            w0.x = pk2(p[0], p[1]); w0.y = pk2(p[2], p[3]); w0.z = pk2(p[4], p[5]); w0.w = pk2(p[6], p[7]);
            w1.x = pk2(p[8], p[9]); w1.y = pk2(p[10], p[11]); w1.z = pk2(p[12], p[13]); w1.w = pk2(p[14], p[15]);
            const bf16x8 pa = __builtin_bit_cast(bf16x8, w0), pb = __builtin_bit_cast(bf16x8, w1);
#pragma unroll
            for (int ct = 0; ct < 4; ++ct) {
                const LAS bf16* vr = Vs + (32 * ct + l31) * VS + 4 * hi + 32 * kh;
                O[ct] = mfma32(cat8(*(const LAS u32x2*)(vr), *(const LAS u32x2*)(vr + 8)), pa, O[ct]);
                O[ct] = mfma32(cat8(*(const LAS u32x2*)(vr + 16), *(const LAS u32x2*)(vr + 24)), pb, O[ct]);
            }
        }
    };
    DSA_GLOAD(0, rk0, rv0); if (nkt > 1) DSA_GLOAD(1, rk1, rv1);
    DSA_LSTORE(0, rk0, rv0);
    __syncthreads();
#pragma unroll 1
    for (int kt = 0; kt < nkt; kt += 2) {
        if (kt + 2 < nkt) DSA_GLOAD(kt + 2, rk0, rv0);
        compute(0, kt);
        if (kt + 1 < nkt) DSA_LSTORE(1, rk1, rv1);
        __syncthreads();
        if (kt + 1 >= nkt) break;
        if (kt + 3 < nkt) DSA_GLOAD(kt + 3, rk1, rv1);
        compute(1, kt + 1);
        if (kt + 2 < nkt) DSA_LSTORE(0, rk0, rv0);
        __syncthreads();
    }
#undef DSA_GLOAD
#undef DSA_LSTORE
    l += __shfl_xor(l, 32);
    const float il = 1.f / l;
    bf16x8 of[8];
#pragma unroll
    for (int ks = 0; ks < 8; ++ks) { const int ct = ks >> 1, o8 = 8 * (ks & 1); u32x4 w;
        w.x = pk2(O[ct][o8 + 0] * il, O[ct][o8 + 1] * il); w.y = pk2(O[ct][o8 + 2] * il, O[ct][o8 + 3] * il);
        w.z = pk2(O[ct][o8 + 4] * il, O[ct][o8 + 5] * il); w.w = pk2(O[ct][o8 + 6] * il, O[ct][o8 + 7] * il); of[ks] = __builtin_bit_cast(bf16x8, w); }
#pragma unroll
    for (int vt = 0; vt < 2; ++vt) {
        f32x16 acc;
#pragma unroll
        for (int i = 0; i < 16; ++i) acc[i] = 0.f;
        const GAS bf16* wr = wuv + (size_t)(h * 64 + 32 * vt + l31) * 128 + 4 * hi;
#pragma unroll
        for (int ks = 0; ks < 8; ++ks) acc = mfma32(cat8(*(const GAS u32x2*)(wr + 16 * ks), *(const GAS u32x2*)(wr + 16 * ks + 8)), of[ks], acc);
#pragma unroll
        for (int g = 0; g < 4; ++g) { u32x2 w; w.x = pk2(acc[4 * g], acc[4 * g + 1]); w.y = pk2(acc[4 * g + 2], acc[4 * g + 3]);
            *(GAS u32x2*)(Y + (rowb + t0 + l31) * DM + 512 + h * 64 + 32 * vt + 8 * g + 4 * hi) = w; }
    }
}

__device__ __forceinline__ void xattn_unit(const Args& a, LAS unsigned char* lds, int b, int h, int qb, int tid, int wave, int lane) {
    constexpr int KS = 264, VS = 72, STG = 36864;
    const GAS bf16* QX = (const GAS bf16*)(a.ws + WS_QX); const GAS bf16* KX = (const GAS bf16*)(a.ws + WS_KX); const GAS bf16* VTX = (const GAS bf16*)(a.ws + WS_VTX); GAS bf16* XO = (GAS bf16*)(a.ws + WS_XO);
    const int fr = lane & 15, fq = lane >> 4; const size_t qrow = (size_t)b * SEQ + qb * 128 + 16 * wave + fr;
    bf16x8 qf[8];
#pragma unroll
    for (int kk = 0; kk < 8; ++kk) qf[kk] = *(const GAS bf16x8*)(QX + qrow * DM + h * 256 + 32 * kk + 8 * fq);
    u32x4 rr[2][4];
    const unsigned vok = (unsigned)((tid >> 5) * DM + 8 * (tid & 31)) * 2u, vov = (unsigned)((tid >> 3) * MEMR + 8 * (tid & 7)) * 2u;
    const GAS char* kxb = (const GAS char*)KX + ((size_t)b * 256 * DM + h * 256) * 2; const GAS char* vxb = (const GAS char*)VTX + ((size_t)h * 256 * MEMR + b * 256) * 2;
    auto gload = [&](int j) {
        if (j < 4) { const GAS char* p_ = kxb + (size_t)j * (64 * DM * 2);
#pragma unroll
            for (int i = 0; i < 4; ++i) rr[j & 1][i] = *(const GAS u32x4*)(p_ + (size_t)(vok + (unsigned)(i * 16 * DM * 2)));
        } else { const GAS char* p_ = vxb + (size_t)(j - 4) * 128;
#pragma unroll
            for (int i = 0; i < 4; ++i) rr[j & 1][i] = *(const GAS u32x4*)(p_ + (size_t)(vov + (unsigned)(i * 64 * MEMR * 2)));
        }
    };
    auto lstore = [&](int j) {
        LAS bf16* base = (LAS bf16*)(lds + (j & 1) * STG);
        if (j < 4) {
#pragma unroll
            for (int i = 0; i < 4; ++i) { const int id = tid + 512 * i; *(LAS u32x4*)(base + (id >> 5) * KS + 8 * (id & 31)) = rr[j & 1][i]; }
        } else {
#pragma unroll
            for (int i = 0; i < 4; ++i) { const int id = tid + 512 * i; *(LAS u32x4*)(base + (id >> 3) * VS + 8 * (id & 7)) = rr[j & 1][i]; }
        }
    };
    f32x4 S[16]; bf16x8 pf[8]; f32x4 O[16]; float l = 0.f;
#pragma unroll
    for (int i = 0; i < 16; ++i) { S[i] = (f32x4){0.f, 0.f, 0.f, 0.f}; O[i] = (f32x4){0.f, 0.f, 0.f, 0.f}; }
    gload(0); gload(1); lstore(0); __syncthreads();
#pragma unroll
    for (int j = 0; j < 8; ++j) {
        if (j < 6) gload(j + 2);
        const LAS bf16* base = (const LAS bf16*)(lds + (j & 1) * STG);
        if (j < 4) {
#pragma unroll
            for (int rt = 0; rt < 4; ++rt)
#pragma unroll
                for (int kk = 0; kk < 8; ++kk) S[4 * j + rt] = mfma16(*(const LAS bf16x8*)(base + (16 * rt + fr) * KS + 32 * kk + 8 * fq), qf[kk], S[4 * j + rt]);
            if (j == 3) {
                float mx = -3.0e38f;
#pragma unroll
                for (int i = 0; i < 16; ++i) mx = fmaxf(mx, fmaxf(fmaxf(S[i][0], S[i][1]), fmaxf(S[i][2], S[i][3])));
                mx = fmaxf(mx, __shfl_xor(mx, 16)); mx = fmaxf(mx, __shfl_xor(mx, 32));
#pragma unroll
                for (int i = 0; i < 16; ++i)
#pragma unroll
                    for (int k = 0; k < 4; ++k) { S[i][k] = __builtin_amdgcn_exp2f(S[i][k] - mx); l += S[i][k]; }
                l += __shfl_xor(l, 16); l += __shfl_xor(l, 32);
#pragma unroll
                for (int c2 = 0; c2 < 8; ++c2) pf[c2] = pack8(S[2 * c2], S[2 * c2 + 1]);
            }
        } else {
            const int mt = j - 4;
#pragma unroll
            for (int dt = 0; dt < 16; ++dt) {
                const LAS bf16* vr = base + (16 * dt + fr) * VS + 4 * fq;
                O[dt] = mfma16(cat8(*(const LAS u32x2*)vr, *(const LAS u32x2*)(vr + 16)), pf[2 * mt], O[dt]);
                O[dt] = mfma16(cat8(*(const LAS u32x2*)(vr + 32), *(const LAS u32x2*)(vr + 48)), pf[2 * mt + 1], O[dt]);
            }
        }
        if (j < 7) lstore(j + 1);
        __syncthreads();
    }
    const float il = 1.f / l;
#pragma unroll
    for (int dt = 0; dt < 16; ++dt) { u32x2 w; w.x = pk2(O[dt][0] * il, O[dt][1] * il); w.y = pk2(O[dt][2] * il, O[dt][3] * il);
        *(GAS u32x2*)(XO + qrow * DM + h * 256 + 16 * dt + 4 * fq) = w; }
}
#ifndef DUP_ML
#define DUP_ML 1
#endif
#ifndef DUP_IDX
#define DUP_IDX 1
#endif
#ifndef DUP_DSA
#define DUP_DSA 1
#endif
#ifndef DUP_XA
#define DUP_XA 1
#endif
#ifndef DUP_PREP
#define DUP_PREP 1
#endif
#define XB_TMO      128
#define XB_XCNT(j)  (256  + 64 * (j))
#define XB_XSUB(j)  (1280 + 64 * (j))
#define XB_XGEN(j)  (2304 + 64 * (j))
#define XB_TOP      3328
#define XB_TOPGEN   3392
#define XCD_BAR_WORDS 3456
#define XB_SPIN_CAP (1u << 18)

__device__ __forceinline__ unsigned xb_ld(unsigned* p)              { return __hip_atomic_load(p, __ATOMIC_RELAXED, __HIP_MEMORY_SCOPE_AGENT); }
__device__ __forceinline__ unsigned xb_add(unsigned* p, unsigned v) { return __hip_atomic_fetch_add(p, v, __ATOMIC_RELAXED, __HIP_MEMORY_SCOPE_AGENT); }
__device__ __forceinline__ unsigned xb_xcc_id() { return (unsigned)__builtin_amdgcn_s_getreg((3 << 11) | 20) & 0xFu; }
#define XB_SPIN(cond, bar) do { unsigned _sp = 0; while (cond) { __builtin_amdgcn_s_sleep(1); \
    if ((++_sp & 255u) == 0u) { if (xb_ld(&(bar)[XB_TMO])) break; if (_sp > XB_SPIN_CAP) { atomicAdd(&(bar)[XB_TMO], 1u); break; } } } } while (0)

struct XcdBarrier {
    unsigned* bar; unsigned x;
    volatile LAS unsigned* st;
};

__device__ __forceinline__ XcdBarrier xcd_barrier_post(unsigned* bar, volatile LAS unsigned* st) {
    XcdBarrier b; b.bar = bar; b.x = xb_xcc_id(); b.st = st;
    if (threadIdx.x == 0) (void)xb_add(&bar[XB_XCNT(b.x)], 1u);
    return b;
}
__device__ __forceinline__ void xcd_barrier_complete(unsigned* bar, unsigned x, unsigned& nloc, unsigned& nx) {
    const unsigned G = gridDim.x * gridDim.y * gridDim.z;
    unsigned sum, cnt, mine, sp = 0u;
    for (;;) {
        sum = 0u; cnt = 0u; mine = 0u;
#pragma unroll
        for (unsigned j = 0; j < 16; ++j) { const unsigned c = xb_ld(&bar[XB_XCNT(j)]); sum += c; cnt += (c > 0u) ? 1u : 0u; mine = (j == x) ? c : mine; }
        if (sum == G) break;
        __builtin_amdgcn_s_sleep(1);
        if ((++sp & 255u) == 0u) { if (xb_ld(&bar[XB_TMO])) break; if (sp > XB_SPIN_CAP) { atomicAdd(&bar[XB_TMO], 1u); break; } }
    }
    nloc = mine > 0u ? mine : 1u; nx = cnt > 0u ? cnt : 1u;
}

__device__ __forceinline__ void xcd_barrier(const XcdBarrier& b) {
    asm volatile("s_waitcnt vmcnt(0)" ::: "memory");
    __syncthreads();
    if (threadIdx.x == 0) {
        unsigned* bar = b.bar;
        __builtin_amdgcn_s_waitcnt(0);
        unsigned nloc = b.st[0], nx = b.st[1];
        if (nloc == 0u) { xcd_barrier_complete(bar, b.x, nloc, nx); b.st[0] = nloc; b.st[1] = nx; }
        const unsigned old = xb_add(&bar[XB_XSUB(b.x)], 1u);
        const unsigned gen = old / nloc;
        if (old + 1u == (gen + 1u) * nloc) {
            __builtin_amdgcn_fence(__ATOMIC_RELEASE, "agent");
            asm volatile("s_waitcnt vmcnt(0)" ::: "memory");
            const unsigned og = xb_add(&bar[XB_TOP], 1u);
            const unsigned tg = og / nx;
            if (og + 1u == (tg + 1u) * nx) xb_add(&bar[XB_TOPGEN], 1u);
            else XB_SPIN(xb_ld(&bar[XB_TOPGEN]) == tg, bar);
            __builtin_amdgcn_fence(__ATOMIC_ACQUIRE, "agent");
            xb_add(&bar[XB_XGEN(b.x)], 1u);
            asm volatile("s_waitcnt vmcnt(0)" ::: "memory");
        } else {
            XB_SPIN(xb_ld(&bar[XB_XGEN(b.x)]) == gen, bar);
            __builtin_amdgcn_fence(__ATOMIC_ACQUIRE, "agent");
            asm volatile("s_waitcnt vmcnt(0)" ::: "memory");
        }
    }
    __syncthreads();
}


constexpr size_t WS_XBAR = 10 * MiB + 32768 + 8192;
constexpr size_t WS_BAR = 10 * MiB + 32768;
__device__ __forceinline__ void grid_bar(GAS unsigned* cnt, unsigned G, unsigned& epoch) {
    asm volatile("s_waitcnt vmcnt(0)" ::: "memory");
    __syncthreads();
    ++epoch;
    if (threadIdx.x == 0) {
        __builtin_amdgcn_fence(__ATOMIC_RELEASE, "agent");
        asm volatile("s_waitcnt vmcnt(0)" ::: "memory");
        __hip_atomic_fetch_add(cnt, 1u, __ATOMIC_RELAXED, __HIP_MEMORY_SCOPE_AGENT);
        const unsigned target = epoch * G; unsigned spins = 0;
        while (__hip_atomic_load(cnt, __ATOMIC_RELAXED, __HIP_MEMORY_SCOPE_AGENT) < target) { __builtin_amdgcn_s_sleep(1); if (++spins > (1u << 24)) break; }
        __builtin_amdgcn_fence(__ATOMIC_ACQUIRE, "agent");
        asm volatile("s_waitcnt vmcnt(0)" ::: "memory");
    }
    __syncthreads();
}
__device__ __forceinline__ void snake_unit(int i, int c, int nb, int& o) { o = i * nb + ((i & 1) ? nb - 1 - c : c); }

__global__ void __launch_bounds__(512, 2) mk_fwd(Args a) {
    extern __shared__ __attribute__((aligned(16))) unsigned char lds_raw[];
    LAS unsigned char* lds = (LAS unsigned char*)lds_raw;

    int tid = threadIdx.x, lane = tid & 63; const int wave = __builtin_amdgcn_readfirstlane(tid >> 6);
    const int G = gridDim.x, vb = blockIdx.x;
    unsigned char* ws = a.ws;
    typedef pg8::bf16_t bt;
#define FRESH_WS() asm volatile("" : "+s"(ws))
    { volatile LAS unsigned* st0 = (volatile LAS unsigned*)(lds + 131072 + 192); if (threadIdx.x == 0) { st0[0] = 0u; st0[1] = 0u; } __syncthreads();
      (void)xcd_barrier_post((unsigned*)(a.ws + WS_XBAR), st0); }
    { LAS unsigned long long* argl = (LAS unsigned long long*)(lds + 131072);
      if (tid == 0) { argl[0] = (unsigned long long)a.x; argl[1] = (unsigned long long)a.convw; argl[2] = (unsigned long long)a.convb; argl[3] = (unsigned long long)a.ibias;
                      argl[4] = (unsigned long long)a.fbias; argl[5] = (unsigned long long)a.headg; argl[6] = (unsigned long long)a.fing; } }
    p0_prologue(a, lds, vb, G, wave, lane);
    if (a.ws == nullptr) cg::this_grid().sync();
    { XcdBarrier xbr; xbr.bar = (unsigned*)(ws + WS_XBAR); xbr.x = xb_xcc_id(); xbr.st = (volatile LAS unsigned*)(lds + 131072 + 192); xcd_barrier(xbr); } FRESH_WS();
    unsigned epoch = 0; (void)epoch;
    { pg8::Gemm g{(const bt*)(ws + WS_XB), (const bt*)(ws + WS_WGU1), NT, 2 * FF, DM}; pg8::StaticOrder S; S.init(NT, 2 * FF, G, vb);
      pg8::EpiAct E{(bt*)(ws + WS_ACT), (const float*)(ws + WS_PARTX)};
      pg8::gemm_phase<pg8::EpiAct, pg8::StaticOrder, true, true>(lds, g, S, E); }
    { XcdBarrier xbr; xbr.bar = (unsigned*)(ws + WS_XBAR); xbr.x = xb_xcc_id(); xbr.st = (volatile LAS unsigned*)(lds + 131072 + 192); xcd_barrier(xbr); } FRESH_WS();
    { pg8::Gemm g{(const bt*)(ws + WS_ACT), (const bt*)(ws + WS_WD1), NT, DM, FF}; pg8::StaticOrder S; S.init(NT, DM, G, vb);
      pg8::EpiResid<false> E{nullptr, (const bt*)(ws + WS_XB), (bt*)(ws + WS_HB), (float*)(ws + WS_PARTA), 0.5f};
      pg8::gemm_phase<pg8::EpiResid<false>, pg8::StaticOrder, true, true>(lds, g, S, E); }
    { XcdBarrier xbr; xbr.bar = (unsigned*)(ws + WS_XBAR); xbr.x = xb_xcc_id(); xbr.st = (volatile LAS unsigned*)(lds + 131072 + 192); xcd_barrier(xbr); } FRESH_WS();
    { pg8::Gemm g{(const bt*)(ws + WS_HB), (const bt*)(ws + WS_WIN), NT, ZW, DM}; pg8::StaticOrder S; S.init(NT, ZW, G, vb);
      pg8::EpiScale<0> E{(bt*)(ws + WS_Z), ZW, (const float*)(ws + WS_PARTA)};
      pg8::gemm_phase<pg8::EpiScale<0>, pg8::StaticOrder, true, true>(lds, g, S, E); }
    { pg8::Gemm g{(const bt*)(ws + WS_MEMB), (const bt*)(ws + WS_WK), MEMR, DM, DM}; pg8::RangeOrder S; S.init(MEMR / 256, DM / 256, G, vb, 128);
      pg8::EpiScale<1> E{(bt*)(ws + WS_KX), DM, (const float*)(ws + WS_RSTDMEM)};
      pg8::gemm_phase<pg8::EpiScale<1>, pg8::RangeOrder, true, true>(lds, g, S, E); }
    { pg8::Gemm g{(const bt*)(ws + WS_WV), (const bt*)(ws + WS_MEMB), DM, MEMR, DM}; pg8::RangeOrder S; S.init(DM / 256, MEMR / 256, G, vb, 192);
      pg8::EpiScale<2> E{(bt*)(ws + WS_VTX), MEMR, (const float*)(ws + WS_RSTDMEM)};
      pg8::gemm_phase<pg8::EpiScale<2>, pg8::RangeOrder, true, true>(lds, g, S, E); }
    { XcdBarrier xbr; xbr.bar = (unsigned*)(ws + WS_XBAR); xbr.x = xb_xcc_id(); xbr.st = (volatile LAS unsigned*)(lds + 131072 + 192); xcd_barrier(xbr); } FRESH_WS();
    { Args a4{}; a4.ws = ws; for (int u = vb; u < NB * 32 * DUP_PREP; u += G) prep_unit(a4, lds, (u >> 5) & 15, u & 31, tid); }
    { XcdBarrier xbr; xbr.bar = (unsigned*)(ws + WS_XBAR); xbr.x = xb_xcc_id(); xbr.st = (volatile LAS unsigned*)(lds + 131072 + 192); xcd_barrier(xbr); } FRESH_WS();
    {
        Args a5{}; a5.ws = ws;
        const int nml = (G > 64) ? 64 : (G > 1 ? G / 2 : 0);
        if (vb < nml) { for (int u = vb; u < 64 * DUP_ML; u += nml) mlstm_unit(a5, lds, (u >> 2) & 15, u & 3, tid, wave, lane); }
        {
            LAS unsigned long long* maskl = (LAS unsigned long long*)(lds + 135168);
            volatile LAS int* slot = (volatile LAS int*)(lds + 131072 + 128);
            const int x = vb & 7; GAS unsigned* qc = (GAS unsigned*)(ws + WS_BAR) + 64 * (1 + x);
            for (;;) {
                if (tid == 0) *slot = (int)__hip_atomic_fetch_add(qc, 1u, __ATOMIC_RELAXED, __HIP_MEMORY_SCOPE_AGENT);
                __syncthreads();
                const int j = __builtin_amdgcn_readfirstlane(*slot);
                if (j >= 128) break;
                const int bb = 2 * x + (j & 1), qb = 63 - (j >> 1);
                _Pragma("unroll 1") for (int hf = 0; hf < 2; ++hf) { int tu = threadIdx.x; asm volatile("" : "+v"(tu)); indexer_unit(a5, lds, maskl + hf * 512, bb, 2 * qb + hf, wave, tu & 63); }
                { int tu = threadIdx.x; asm volatile("" : "+v"(tu)); dsa_unit32(a5, lds, maskl, bb, qb, tu, wave, tu & 63); }
            }
        }
    }
    { XcdBarrier xbr; xbr.bar = (unsigned*)(ws + WS_XBAR); xbr.x = xb_xcc_id(); xbr.st = (volatile LAS unsigned*)(lds + 131072 + 192); xcd_barrier(xbr); } FRESH_WS();
    { pg8::Gemm g{(const bt*)(ws + WS_Y), (const bt*)(ws + WS_WOUT), NT, DM, DM}; pg8::StaticOrder S; S.init(NT, DM, G, vb);
      pg8::EpiResid<false> E{nullptr, (const bt*)(ws + WS_HB), (bt*)(ws + WS_HB), (float*)(ws + WS_PARTB), 1.0f};
      pg8::gemm_phase<pg8::EpiResid<false>, pg8::StaticOrder, true, true>(lds, g, S, E); }
    { XcdBarrier xbr; xbr.bar = (unsigned*)(ws + WS_XBAR); xbr.x = xb_xcc_id(); xbr.st = (volatile LAS unsigned*)(lds + 131072 + 192); xcd_barrier(xbr); } FRESH_WS();
    { pg8::Gemm g{(const bt*)(ws + WS_HB), (const bt*)(ws + WS_WQ), NT, DM, DM}; pg8::StaticOrder S; S.init(NT, DM, G, vb);
      pg8::EpiScale<0> E{(bt*)(ws + WS_QX), DM, (const float*)(ws + WS_PARTB)};
      pg8::gemm_phase<pg8::EpiScale<0>, pg8::StaticOrder, true, true>(lds, g, S, E); }
    { XcdBarrier xbr; xbr.bar = (unsigned*)(ws + WS_XBAR); xbr.x = xb_xcc_id(); xbr.st = (volatile LAS unsigned*)(lds + 131072 + 192); xcd_barrier(xbr); } FRESH_WS();
    Args a6{}; a6.ws = ws;
    if ((G & 7) == 0) { const int x = vb & 7, r = vb >> 3, nr = G >> 3;
        const int per = (128 + nr - 1) / nr;
        for (int w = r * per; w < 128 && w < (r + 1) * per; ++w) { int tu = threadIdx.x; asm volatile("" : "+v"(tu)); const int pr = x * 8 + (w >> 4); xattn_unit(a6, lds, pr >> 2, pr & 3, w & 15, tu, wave, tu & 63); } }
    else for (int u = vb; u < NB * 4 * 16; u += G) { int tu = threadIdx.x; asm volatile("" : "+v"(tu)); xattn_unit(a6, lds, (u >> 6) & 15, (u >> 4) & 3, u & 15, tu, wave, tu & 63); }
    { XcdBarrier xbr; xbr.bar = (unsigned*)(ws + WS_XBAR); xbr.x = xb_xcc_id(); xbr.st = (volatile LAS unsigned*)(lds + 131072 + 192); xcd_barrier(xbr); } FRESH_WS();
    { pg8::Gemm g{(const bt*)(ws + WS_XO), (const bt*)(ws + WS_WO), NT, DM, DM}; pg8::StaticOrder S; S.init(NT, DM, G, vb);
      pg8::EpiResid<false> E{nullptr, (const bt*)(ws + WS_HB), (bt*)(ws + WS_HB), (float*)(ws + WS_PARTC), 1.0f};
      pg8::gemm_phase<pg8::EpiResid<false>, pg8::StaticOrder, true, true>(lds, g, S, E); }
    { XcdBarrier xbr; xbr.bar = (unsigned*)(ws + WS_XBAR); xbr.x = xb_xcc_id(); xbr.st = (volatile LAS unsigned*)(lds + 131072 + 192); xcd_barrier(xbr); } FRESH_WS();
    { pg8::Gemm g{(const bt*)(ws + WS_HB), (const bt*)(ws + WS_WGU2), NT, 2 * FF, DM}; pg8::StaticOrder S; S.init(NT, 2 * FF, G, vb);
      pg8::EpiAct E{(bt*)(ws + WS_ACT), (const float*)(ws + WS_PARTC)};
      pg8::gemm_phase<pg8::EpiAct, pg8::StaticOrder, true, true>(lds, g, S, E); }
    { XcdBarrier xbr; xbr.bar = (unsigned*)(ws + WS_XBAR); xbr.x = xb_xcc_id(); xbr.st = (volatile LAS unsigned*)(lds + 131072 + 192); xcd_barrier(xbr); } FRESH_WS();
    { pg8::Gemm g{(const bt*)(ws + WS_ACT), (const bt*)(ws + WS_WD2), NT, DM, FF}; pg8::StaticOrder S; S.init(NT, DM, G, vb);
      pg8::EpiResid<false> E{nullptr, (const bt*)(ws + WS_HB), (bt*)(ws + WS_HB), (float*)(ws + WS_PARTD), 0.5f};
      pg8::gemm_phase<pg8::EpiResid<false>, pg8::StaticOrder, true, true>(lds, g, S, E); }
    { XcdBarrier xbr; xbr.bar = (unsigned*)(ws + WS_XBAR); xbr.x = xb_xcc_id(); xbr.st = (volatile LAS unsigned*)(lds + 131072 + 192); xcd_barrier(xbr); } FRESH_WS();
    {
        int tid13 = threadIdx.x; asm volatile("" : "+v"(tid13)); const int lane = tid13 & 63;
        const GAS float* parts = (const GAS float*)(ws + WS_PARTD); const GAS float* fingp = LDPTR(6);
        const GAS bf16* hbp = (const GAS bf16*)(ws + WS_HB);
        f32x4 gg[4];
#pragma unroll
        for (int j = 0; j < 4; ++j) gg[j] = ((const GAS f32x4*)fingp)[lane + 64 * j];
        for (int m0 = 2 * (vb * 8 + wave); m0 < NT; m0 += 2 * G * 8) {
            u32x2 hw[2][4]; float sp[2];
#pragma unroll
            for (int rr = 0; rr < 2; ++rr) { const int m = m0 + rr; sp[rr] = lane < 16 ? parts[(size_t)m * 16 + lane] : 0.f; const GAS u32x2* hr = (const GAS u32x2*)(hbp + (size_t)m * DM) + lane;
#pragma unroll
                for (int j = 0; j < 4; ++j) hw[rr][j] = __builtin_nontemporal_load(&hr[64 * j]); }
#pragma unroll
            for (int rr = 0; rr < 2; ++rr) { const int m = m0 + rr; const float s = wave_sum(sp[rr]); const float rs = rsqrtf(s * (1.f / 1024.f) + EPS);
                GAS f32x4* o = (GAS f32x4*)(a.out + (size_t)m * DM) + lane;
#pragma unroll
                for (int j = 0; j < 4; ++j) { const u32x2 w = hw[rr][j]; const f32x4 v = {bflo(w.x), bfhi(w.x), bflo(w.y), bfhi(w.y)}; __builtin_nontemporal_store(v * rs * gg[j], &o[64 * j]); } }
        }
    }
}

extern "C" void kernel_launch(void* const* d_in, const int* in_sizes, int n_in, void* d_out, int out_size, void* d_ws, size_t ws_size, hipStream_t stream) {
    static int grid = 0;
    if (grid == 0) {
        int dev = 0, cus = 0, per_cu = 0;
        if (n_in != 27 || out_size != NT * DM || ws_size < WS_END) { fprintf(stderr, "kernel_launch: unexpected problem (n_in %d out %d ws %zu)\n", n_in, out_size, ws_size); grid = -1; return; }
        (void)hipGetDevice(&dev);
        (void)hipDeviceGetAttribute(&cus, hipDeviceAttributeMultiprocessorCount, dev);
        (void)hipFuncSetAttribute((const void*)mk_fwd, hipFuncAttributeMaxDynamicSharedMemorySize, LDS_BYTES);
        (void)hipOccupancyMaxActiveBlocksPerMultiprocessor(&per_cu, (const void*)mk_fwd, 512, LDS_BYTES);
        (void)hipGetLastError();
        if (per_cu < 1) per_cu = 1;
        grid = cus > 0 ? cus : 256;
    }
    if (grid < 0) return;
    (void)hipMemsetAsync((char*)d_ws + WS_BAR, 0, 8192 + 16384, stream);
    Args a{};
    const float** f = (const float**)&a;
    for (int i = 0; i < 27; ++i) f[i] = (const float*)d_in[i];
    a.out = (float*)d_out; a.ws = (unsigned char*)d_ws;
    void* args[] = {&a};
    hipError_t e = hipLaunchCooperativeKernel((const void*)mk_fwd, dim3(grid), dim3(512), args, LDS_BYTES, stream);
    if (e != hipSuccess) fprintf(stderr, "cooperative launch failed: %s (grid %d)\n", hipGetErrorString(e), grid);
}
```

```cpp
#include <hip/hip_runtime.h>
#include <hip/hip_cooperative_groups.h>
#include <cstdio>
#include <cstdint>
namespace cg = cooperative_groups;
namespace pg8 {
#define PG8_LAS __attribute__((address_space(3)))
typedef unsigned short bf16_t;
typedef short bf16x8 __attribute__((ext_vector_type(8)));
typedef float f32x4 __attribute__((ext_vector_type(4)));
typedef unsigned u32x4 __attribute__((ext_vector_type(4)));
constexpr int BM = 256, BK = 64, HALF = 128, HTB = HALF * BK * 2  , STAGE_BYTES = 8 * HTB, NXCD = 8, WGM = 8;

__host__ __device__ __forceinline__ int lds_byte(int r, int c) { const int st = (r >> 4) * 2 + (c >> 5), rr = r & 15, cc = c & 31, ob = rr * 64 + cc * 2; return st * 1024 + (ob ^ (((ob >> 9) & 1) << 5)); }
__host__ __device__ __forceinline__ void stage_rc(int b, int& R, int& C) { const int st = b / 1024, sb = b % 1024, swz = sb ^ (((sb >> 9) & 1) << 5); R = (st >> 1) * 16 + swz / 64; C = (st & 1) * 32 + (swz % 64) / 2; }
__host__ __device__ __forceinline__ int perm32(int rho) { const int n = rho >> 4, i = rho & 15; return 8 * (i >> 2) + 4 * n + (i & 3); }

struct Unit { int pm, pn; };
struct Gemm { const bf16_t* A; const bf16_t* Bt; int M, N, K; };

struct StaticOrder {
    int nM, nN, nwg, G, c;
    __host__ __device__ void init(int M, int N, int G_, int c_) { nM = M / BM; nN = N / BM; nwg = nM * nN; G = G_; c = c_; }
    __host__ __device__ bool next(int i, Unit& u) const {
        const long L = (long)i * G + c; if (L >= nwg) return false;
        int wgid = (int)L; { const int q = nwg / NXCD, r = nwg % NXCD, xcd = wgid % NXCD, off = wgid / NXCD; wgid = (xcd < r ? xcd * (q + 1) : r * (q + 1) + (xcd - r) * q) + off; }
        const int nig = WGM * nN, gid = wgid / nig, fm = gid * WGM, gsz = (nM - fm) < WGM ? (nM - fm) : WGM;
        u.pm = fm + ((wgid % nig) % gsz); u.pn = (wgid % nig) / gsz; return true;
    }
    __device__ __forceinline__ void a_ready(const Unit&) const {}
    __device__ __forceinline__ void done(const Unit&) const {}
};

__device__ __forceinline__ unsigned cvt_pk_bf16(float lo, float hi) { unsigned r; asm volatile("v_cvt_pk_bf16_f32 %0, %1, %2" : "=v"(r) : "v"(lo), "v"(hi)); return r; }
#define PG8_GAS __attribute__((address_space(1)))
constexpr float RMS_EPS = 1e-6f;
__device__ __forceinline__ unsigned f2bf_(float f) { unsigned u = __builtin_bit_cast(unsigned, f); return (u + 0x7fffu + ((u >> 16) & 1u)) >> 16; }
typedef float f32x2c_t __attribute__((ext_vector_type(2))); typedef __bf16 bf16x2c_t __attribute__((ext_vector_type(2)));
__device__ __forceinline__ unsigned pk2_(float lo, float hi) { f32x2c_t v = {lo, hi}; bf16x2c_t b = __builtin_convertvector(v, bf16x2c_t); return __builtin_bit_cast(unsigned, b); }
__device__ __forceinline__ float row_rstd(const float* parts, int r, int fq) {
    const f32x4 p = *(const PG8_GAS f32x4*)(parts + (size_t)r * 16 + 4 * fq);
    float s = (p[0] + p[1]) + (p[2] + p[3]);
    s += __shfl_xor(s, 16); s += __shfl_xor(s, 32);
    return rsqrtf(s * (1.0f / 1024.0f) + RMS_EPS);
}
__device__ __forceinline__ float silu_f(float x) { return x * __builtin_amdgcn_rcpf(1.0f + __builtin_amdgcn_exp2f(-1.4426950408889634f * x)); }
struct EpiAct {
    static constexpr bool PERM = true, AFTER_DRAIN = false;
    bf16_t* O; const float* parts;
    __device__ __forceinline__ void operator()(const f32x4 (&acc)[2][2][4][2], const Unit& u, int wr, int wc, int fr, int fq) const {
        const int row0 = u.pm * BM + wr * 64 + fr, col0 = u.pn * 128 + wc * 32 + 8 * fq;
        float rs8[2][4];
#pragma unroll
        for (int ai = 0; ai < 2; ++ai)
#pragma unroll
            for (int m = 0; m < 4; ++m) rs8[ai][m] = row_rstd(parts, row0 + ai * HALF + m * 16, fq);
#pragma unroll
        for (int ai = 0; ai < 2; ++ai)
#pragma unroll
            for (int m = 0; m < 4; ++m) {
                const int r = row0 + ai * HALF + m * 16; const float s = rs8[ai][m];
                float o[8];
#pragma unroll
                for (int n = 0; n < 2; ++n)
#pragma unroll
                    for (int i = 0; i < 4; ++i) o[4 * n + i] = silu_f(acc[ai][0][m][n][i] * s) * (acc[ai][1][m][n][i] * s);
                u32x4 w; w.x = pk2_(o[0], o[1]); w.y = pk2_(o[2], o[3]); w.z = pk2_(o[4], o[5]); w.w = pk2_(o[6], o[7]);
                *(PG8_GAS u32x4*)(O + (size_t)r * 2816 + col0) = w;
            }
    }
};
template <int MODE> struct EpiScale {
    static constexpr bool PERM = true, AFTER_DRAIN = false;
    bf16_t* O; int ldc; const float* sc;
    __device__ __forceinline__ void operator()(const f32x4 (&acc)[2][2][4][2], const Unit& u, int wr, int wc, int fr, int fq) const {
        const int row0 = u.pm * BM + wr * 64 + fr, col0 = u.pn * BM + wc * 32 + 8 * fq;
        float rs8[2][4];
#pragma unroll
        for (int ai = 0; ai < 2; ++ai)
#pragma unroll
            for (int m = 0; m < 4; ++m) { const int r = row0 + ai * HALF + m * 16; rs8[ai][m] = MODE == 0 ? row_rstd(sc, r, fq) : (MODE == 1 ? ((const PG8_GAS float*)sc)[r] : 1.f); }
        f32x4 cs[2][2];
        if (MODE == 2) {
#pragma unroll
            for (int bj = 0; bj < 2; ++bj)
#pragma unroll
                for (int n = 0; n < 2; ++n) cs[bj][n] = *(const PG8_GAS f32x4*)(sc + col0 + bj * HALF + 4 * n);
        }
#pragma unroll
        for (int ai = 0; ai < 2; ++ai)
#pragma unroll
            for (int m = 0; m < 4; ++m) {
                const int r = row0 + ai * HALF + m * 16;
                const float s = rs8[ai][m];
#pragma unroll
                for (int bj = 0; bj < 2; ++bj) {
                    f32x4 v0 = acc[ai][bj][m][0], v1 = acc[ai][bj][m][1];
                    if (MODE == 2) { v0 = v0 * cs[bj][0]; v1 = v1 * cs[bj][1]; } else { v0 = v0 * s; v1 = v1 * s; }
                    u32x4 w; w.x = pk2_(v0[0], v0[1]); w.y = pk2_(v0[2], v0[3]); w.z = pk2_(v1[0], v1[1]); w.w = pk2_(v1[2], v1[3]);
                    *(PG8_GAS u32x4*)(O + (size_t)r * ldc + col0 + bj * HALF) = w;
                }
            }
    }
};
template <bool BASE_F32> struct EpiResid {
    static constexpr bool PERM = false, AFTER_DRAIN = false;
    const float* base; const bf16_t* hbase; bf16_t* hb; float* parts; float alpha;
    __device__ __forceinline__ void operator()(const f32x4 (&acc)[2][2][4][2], const Unit& u, int wr, int wc, int fr, int fq) const {
        typedef unsigned u32x2v __attribute__((ext_vector_type(2)));
        const int row0 = u.pm * BM + wr * 64 + fr, col0 = u.pn * BM + wc * 32 + 4 * fq;
        u32x2v bsv[2][4][2][2];
#pragma unroll
        for (int ai = 0; ai < 2; ++ai)
#pragma unroll
            for (int m = 0; m < 4; ++m) { const size_t off = (size_t)(row0 + ai * HALF + m * 16) * 1024 + col0;
#pragma unroll
                for (int bj = 0; bj < 2; ++bj)
#pragma unroll
                    for (int n = 0; n < 2; ++n) bsv[ai][m][bj][n] = *(const PG8_GAS u32x2v*)(hbase + off + bj * HALF + n * 16); }
#pragma unroll
        for (int ai = 0; ai < 2; ++ai)
#pragma unroll
            for (int m = 0; m < 4; ++m) {
                const int r = row0 + ai * HALF + m * 16; const size_t off = (size_t)r * 1024 + col0; float ss = 0.f;
#pragma unroll
                for (int bj = 0; bj < 2; ++bj)
#pragma unroll
                    for (int n = 0; n < 2; ++n) {
                        const u32x2v w0 = bsv[ai][m][bj][n]; f32x4 bs;
                        bs[0] = __builtin_bit_cast(float, w0.x << 16); bs[1] = __builtin_bit_cast(float, w0.x & 0xffff0000u); bs[2] = __builtin_bit_cast(float, w0.y << 16); bs[3] = __builtin_bit_cast(float, w0.y & 0xffff0000u);
                        const f32x4 v = bs + acc[ai][bj][m][n] * alpha;
                        { u32x2v w; w.x = pk2_(v[0], v[1]); w.y = pk2_(v[2], v[3]); *(PG8_GAS u32x2v*)(hb + off + bj * HALF + n * 16) = w; }
                        ss += (v[0] * v[0] + v[1] * v[1]) + (v[2] * v[2] + v[3] * v[3]);
                    }
                ss += __shfl_xor(ss, 16); ss += __shfl_xor(ss, 32);
                if (fq == 0) ((PG8_GAS float*)parts)[(size_t)r * 16 + u.pn * 4 + wc] = ss;
            }
    }
};
struct RangeOrder {
    int n, nN, G, c0;
    __device__ void init(int nM_, int nN_, int G_, int c_, int shift) { n = nM_ * nN_; nN = nN_; G = G_; c0 = (c_ + G_ - (shift % G_)) % G_; }
    __device__ bool next(int i, Unit& u) const { const long L = (long)i * G + c0; if (L >= n) return false; u.pm = (int)L / nN; u.pn = (int)L % nN; return true; }
    __device__ __forceinline__ void a_ready(const Unit&) const {}
    __device__ __forceinline__ void done(const Unit&) const {}
};
template <class Epi, class Sched, bool ALIGN_EPI = false, bool SP2 = false>
__device__ __forceinline__ void gemm_phase(PG8_LAS unsigned char* lds, const Gemm g, const Sched& S, const Epi& E) {
    int tid_ = threadIdx.x; asm volatile("" : "+v"(tid_));
    const int tid = tid_, wid = __builtin_amdgcn_readfirstlane(tid >> 6), lane = tid & 63, wr = wid >> 2, wc = wid & 3, fr = lane & 15, fq = lane >> 4;
    const int K = g.K, nt = K / BK;
    unsigned voffA, voffB;
    { int R, C; stage_rc(tid * 16, R, C); const int Rb = Epi::PERM ? ((R & ~31) + perm32(R & 31)) : R;
      voffA = (unsigned)(R * K + C) * 2u; voffB = (unsigned)(Rb * K + C) * 2u; }
    const size_t rstep64 = (size_t)64 * K * 2;
    const size_t kstep = (size_t)(BK * 2);
    const size_t hstep = (size_t)HALF * K * 2;
    const size_t tstep = 2 * hstep;
    const unsigned ldsw = (unsigned)wid * 1024u;
    const int aoff = lds_byte(wr * 64 + fr, fq * 8), boff = lds_byte(wc * 32 + fr, fq * 8);
#define PG8_SA(b, h) (((b) * 2 + (h)) * HTB)
#define PG8_SB(b, h) ((4 + (b) * 2 + (h)) * HTB)
#define PG8_STAGE(bufoff, gbase, voff) do { _Pragma("unroll") for (int _i = 0; _i < 2; ++_i) \
        __builtin_amdgcn_global_load_lds((const unsigned*)(((const char*)(gbase) + _i * rstep64) + (voff)), (PG8_LAS unsigned*)(lds + (bufoff) + ldsw + _i * 8192), 16, 0, 0); } while (0)
#define PG8_LDA(dst, b, h) do { _Pragma("unroll") for (int m = 0; m < 4; ++m) _Pragma("unroll") for (int k = 0; k < 2; ++k) dst[m][k] = *(const PG8_LAS bf16x8*)(lds + PG8_SA(b, h) + aoff + m * 2048 + k * 1024); } while (0)
#define PG8_LDB(dst, b, h) do { _Pragma("unroll") for (int n = 0; n < 2; ++n) _Pragma("unroll") for (int k = 0; k < 2; ++k) dst[n][k] = *(const PG8_LAS bf16x8*)(lds + PG8_SB(b, h) + boff + n * 2048 + k * 1024); } while (0)
#define PG8_MMA(ai, bj, At, Bt) do { __builtin_amdgcn_s_setprio(1); _Pragma("unroll") for (int m = 0; m < 4; ++m) _Pragma("unroll") for (int n = 0; n < 2; ++n) _Pragma("unroll") for (int k = 0; k < 2; ++k) \
        acc[ai][bj][m][n] = __builtin_amdgcn_mfma_f32_16x16x32_bf16(Bt[n][k], At[m][k], acc[ai][bj][m][n], 0, 0, 0); __builtin_amdgcn_s_setprio(0); } while (0)
#define PG8_WAIT_V(n) asm volatile("s_waitcnt vmcnt(" #n ")" ::: "memory")
#define PG8_WAIT_L(n) asm volatile("s_waitcnt lgkmcnt(" #n ")" ::: "memory")
#define PG8_BAR __builtin_amdgcn_s_barrier()
#define PG8_SCHED __builtin_amdgcn_sched_barrier(0)
    Unit cur, nxt; int ui = 0;
    if (!S.next(0, cur)) return;
    f32x4 acc[2][2][4][2];
#pragma unroll
    for (int a = 0; a < 2; ++a)
#pragma unroll
        for (int b = 0; b < 2; ++b)
#pragma unroll
            for (int m = 0; m < 4; ++m)
#pragma unroll
                for (int n = 0; n < 2; ++n) acc[a][b][m][n] = (f32x4){0.f, 0.f, 0.f, 0.f};
    bf16x8 At[4][2], B0[2][2], B1[2][2];
    const char* cA = (const char*)g.A + (size_t)cur.pm * tstep; const char* cB = (const char*)g.Bt + (size_t)cur.pn * tstep;
    S.a_ready(cur);
    if constexpr (SP2) {
        PG8_STAGE(PG8_SB(0, 0), cB, voffB); PG8_STAGE(PG8_SB(0, 1), cB + hstep, voffB); PG8_STAGE(PG8_SA(0, 0), cA, voffA); PG8_STAGE(PG8_SA(0, 1), cA + hstep, voffA);
        if (wr == 1) PG8_BAR;
        PG8_WAIT_V(2); PG8_BAR;
        PG8_STAGE(PG8_SB(1, 0), cB + kstep, voffB); PG8_STAGE(PG8_SA(1, 0), cA + kstep, voffA); PG8_STAGE(PG8_SB(1, 1), cB + hstep + kstep, voffB);
        PG8_WAIT_V(6); PG8_BAR;
    } else {
        PG8_STAGE(PG8_SB(0, 0), cB, voffB); PG8_STAGE(PG8_SA(0, 0), cA, voffA); PG8_STAGE(PG8_SB(0, 1), cB + hstep, voffB); PG8_STAGE(PG8_SA(0, 1), cA + hstep, voffA);
        if (wr == 1) PG8_BAR;
        PG8_WAIT_V(4); PG8_BAR;
        PG8_STAGE(PG8_SB(1, 0), cB + kstep, voffB); PG8_STAGE(PG8_SA(1, 0), cA + kstep, voffA); PG8_STAGE(PG8_SB(1, 1), cB + hstep + kstep, voffB);
        PG8_WAIT_V(6); PG8_BAR;
    }
    for (;;) {
        const bool has_next = S.next(ui + 1, nxt);
        const char* nA = has_next ? (const char*)g.A + (size_t)nxt.pm * tstep : cA; const char* nB = has_next ? (const char*)g.Bt + (size_t)nxt.pn * tstep : cB;
        for (int t = 0; t < nt; t += 2) {
            const bool last = (t == nt - 2);
            const char* a1 = cA + (size_t)(t + 1) * kstep;
            const char* a2 = last ? nA : cA + (size_t)(t + 2) * kstep; const char* b2 = last ? nB : cB + (size_t)(t + 2) * kstep;
            const char* a3 = a2 + kstep; const char* b3 = b2 + kstep;
            if (last && has_next) S.a_ready(nxt);
            if constexpr (SP2) {
            PG8_LDB(B0, 0, 0); PG8_LDB(B1, 0, 1); PG8_SCHED; PG8_LDA(At, 0, 0); PG8_STAGE(PG8_SA(1, 1), a1 + hstep, voffA);
            PG8_WAIT_V(8); PG8_WAIT_L(0); PG8_BAR; PG8_MMA(0, 0, At, B0); PG8_MMA(0, 1, At, B1); PG8_BAR; PG8_SCHED;
            PG8_LDA(At, 0, 1); PG8_STAGE(PG8_SB(0, 0), b2, voffB); PG8_STAGE(PG8_SB(0, 1), b2 + hstep, voffB); PG8_STAGE(PG8_SA(0, 0), a2, voffA);
            PG8_WAIT_V(8); PG8_WAIT_L(0); PG8_BAR; PG8_MMA(1, 0, At, B0); PG8_MMA(1, 1, At, B1); PG8_BAR; PG8_SCHED;
            PG8_LDB(B0, 1, 0); PG8_LDB(B1, 1, 1); PG8_SCHED; PG8_LDA(At, 1, 0); PG8_STAGE(PG8_SA(0, 1), a2 + hstep, voffA);
            PG8_WAIT_V(8); PG8_WAIT_L(0); PG8_BAR; PG8_MMA(0, 0, At, B0); PG8_MMA(0, 1, At, B1); PG8_BAR; PG8_SCHED;
            PG8_LDA(At, 1, 1); PG8_STAGE(PG8_SB(1, 0), b3, voffB); PG8_STAGE(PG8_SB(1, 1), b3 + hstep, voffB); PG8_STAGE(PG8_SA(1, 0), a3, voffA);
            PG8_WAIT_V(8); PG8_WAIT_L(0); PG8_BAR; PG8_MMA(1, 0, At, B0); PG8_MMA(1, 1, At, B1); PG8_BAR; PG8_SCHED;
            } else {
            PG8_LDB(B0, 0, 0); PG8_SCHED; PG8_LDA(At, 0, 0); PG8_STAGE(PG8_SA(1, 1), a1 + hstep, voffA);
            PG8_WAIT_L(8); PG8_BAR; PG8_WAIT_L(0); PG8_MMA(0, 0, At, B0); PG8_BAR; PG8_SCHED;
            PG8_LDB(B1, 0, 1); PG8_STAGE(PG8_SB(0, 0), b2, voffB);
            PG8_BAR; PG8_WAIT_L(0); PG8_MMA(0, 1, At, B1); PG8_BAR;
            PG8_LDA(At, 0, 1); PG8_STAGE(PG8_SA(0, 0), a2, voffA);
            PG8_BAR; PG8_WAIT_L(0); PG8_MMA(1, 0, At, B0); PG8_BAR; PG8_SCHED;
            PG8_STAGE(PG8_SB(0, 1), b2 + hstep, voffB);
            PG8_WAIT_V(6); PG8_BAR; PG8_MMA(1, 1, At, B1); PG8_BAR;
            PG8_LDB(B0, 1, 0); PG8_SCHED; PG8_LDA(At, 1, 0); PG8_STAGE(PG8_SA(0, 1), a2 + hstep, voffA);
            PG8_WAIT_L(8); PG8_BAR; PG8_WAIT_L(0); PG8_MMA(0, 0, At, B0); PG8_BAR; PG8_SCHED;
            PG8_LDB(B1, 1, 1); PG8_STAGE(PG8_SB(1, 0), b3, voffB);
            PG8_BAR; PG8_WAIT_L(0); PG8_MMA(0, 1, At, B1); PG8_BAR;
            PG8_LDA(At, 1, 1); PG8_STAGE(PG8_SA(1, 0), a3, voffA);
            PG8_BAR; PG8_WAIT_L(0); PG8_MMA(1, 0, At, B0); PG8_BAR; PG8_SCHED;
            PG8_STAGE(PG8_SB(1, 1), b3 + hstep, voffB);
            PG8_WAIT_V(6); PG8_BAR; PG8_MMA(1, 1, At, B1); PG8_BAR;
            }
        }
        if constexpr (ALIGN_EPI) { if (wr == 0) PG8_BAR; }
        if constexpr (!Epi::AFTER_DRAIN) { int t2 = threadIdx.x; asm volatile("" : "+v"(t2)); E(acc, cur, wr, wc, t2 & 15, (t2 >> 4) & 3); S.done(cur); }
        if (!has_next) break;
#pragma unroll
        for (int a = 0; a < 2; ++a)
#pragma unroll
            for (int b = 0; b < 2; ++b)
#pragma unroll
                for (int m = 0; m < 4; ++m)
#pragma unroll
                    for (int n = 0; n < 2; ++n) acc[a][b][m][n] = (f32x4){0.f, 0.f, 0.f, 0.f};
        cur = nxt; cA = nA; cB = nB; ++ui;
        if constexpr (ALIGN_EPI) { if (wr == 1) PG8_BAR; }
    }
    PG8_WAIT_V(0);
    if constexpr (!ALIGN_EPI) { if (wr == 0) PG8_BAR; }
    PG8_BAR;
    if constexpr (Epi::AFTER_DRAIN) { E.fused(acc, cur, wr, wc, fr, fq, lds, wid, lane); S.done(cur); }
#undef PG8_SA
#undef PG8_SB
#undef PG8_STAGE
#undef PG8_LDA
#undef PG8_LDB
#undef PG8_MMA
#undef PG8_WAIT_V
#undef PG8_WAIT_L
#undef PG8_BAR
#undef PG8_SCHED
}
}
#define LAS __attribute__((address_space(3)))
#define GAS __attribute__((address_space(1)))
typedef unsigned short bf16;
typedef short bf16x8 __attribute__((ext_vector_type(8)));
typedef short s16x4 __attribute__((ext_vector_type(4)));
typedef float f32x4 __attribute__((ext_vector_type(4)));
typedef unsigned u32x4 __attribute__((ext_vector_type(4)));
typedef unsigned u32x2 __attribute__((ext_vector_type(2)));
constexpr int NT = 32768, DM = 1024, FF = 2816, SEQ = 2048, NB = 16, ZW = 3840, MEMR = 4096;
constexpr int ZQ = 0, ZK = 512, ZV = 1024, ZO = 1536, ZDQ = 2048, ZDC = 3072, ZIQ = 3200, ZIK = 3712, ZMI = 3776, ZMF = 3780, ZIW = 3784;
constexpr float EPS = 1e-6f, LOG2E = 1.4426950408889634f;
constexpr size_t MiB = 1u << 20;
constexpr size_t WS_PARTX = 0, WS_PARTA = 2 * MiB, WS_PARTB = 4 * MiB, WS_PARTC = 6 * MiB, WS_PARTD = 8 * MiB, WS_RSTDMEM = 10 * MiB, WS_WUV = 10 * MiB + 65536;
constexpr size_t WS_WGU1 = 16 * MiB, WS_WD1 = 27 * MiB, WS_WGU2 = 33 * MiB, WS_WD2 = 44 * MiB, WS_WIN = 50 * MiB, WS_WOUT = 58 * MiB, WS_WQ = 60 * MiB, WS_WK = 62 * MiB, WS_WV = 64 * MiB, WS_WO = 66 * MiB;
constexpr size_t WS_HB = 68 * MiB, WS_XB = 132 * MiB, WS_ACT = 196 * MiB, WS_Z = 132 * MiB, WS_QX = 132 * MiB, WS_XO = 196 * MiB, WS_Y = 372 * MiB;
constexpr size_t WS_CKV = 436 * MiB, WS_CKVT = 444 * MiB, WS_IKN = 452 * MiB, WS_MASK = 456 * MiB, WS_KX = 464 * MiB, WS_VTX = 472 * MiB, WS_MEMB = 480 * MiB, WS_END = 488 * MiB;
constexpr int LDS_BYTES = 147456;

struct Args {
    const float *x, *mem, *f1g, *f1wg, *f1wu, *f1wd, *mixg, *win, *convw, *convb, *ibias, *fbias, *headg, *kvg, *idxg, *wuv, *wout,
        *xag, *memg, *xwq, *xwkv, *xwo, *f2g, *f2wg, *f2wu, *f2wd, *fing;
    float* out; unsigned char* ws;
};

__device__ __forceinline__ unsigned f2bf(float f) { unsigned u = __builtin_bit_cast(unsigned, f); return (u + 0x7fffu + ((u >> 16) & 1u)) >> 16; }
typedef float f32x2_t __attribute__((ext_vector_type(2))); typedef __bf16 bf16x2_t __attribute__((ext_vector_type(2)));
__device__ __forceinline__ unsigned pk2(float lo, float hi) { f32x2_t v = {lo, hi}; bf16x2_t b = __builtin_convertvector(v, bf16x2_t); return __builtin_bit_cast(unsigned, b); }
__device__ __forceinline__ float bf2f(unsigned short v) { return __builtin_bit_cast(float, (unsigned)v << 16); }
__device__ __forceinline__ float bflo(unsigned w) { return __builtin_bit_cast(float, w << 16); }
__device__ __forceinline__ float bfhi(unsigned w) { return __builtin_bit_cast(float, w & 0xffff0000u); }
__device__ __forceinline__ float wave_sum(float v) {
#pragma unroll
    for (int o = 1; o < 64; o <<= 1) v += __shfl_xor(v, o);
    return v;
}
__device__ __forceinline__ f32x4 mfma16(bf16x8 a, bf16x8 b, f32x4 c) { return __builtin_amdgcn_mfma_f32_16x16x32_bf16(a, b, c, 0, 0, 0); }
__device__ __forceinline__ bf16x8 cat8(u32x2 lo, u32x2 hi) { u32x4 w; w.x = lo.x; w.y = lo.y; w.z = hi.x; w.w = hi.y; return __builtin_bit_cast(bf16x8, w); }
__device__ __forceinline__ bf16x8 pack8(f32x4 a, f32x4 b) { u32x4 w; w.x = pk2(a[0], a[1]); w.y = pk2(a[2], a[3]); w.z = pk2(b[0], b[1]); w.w = pk2(b[2], b[3]); return __builtin_bit_cast(bf16x8, w); }

#define LDPTR(i) ({ volatile LAS unsigned* p_ = (volatile LAS unsigned*)(lds + 131072 + 8 * (i)); const unsigned lo_ = __builtin_amdgcn_readfirstlane(p_[0]), hi_ = __builtin_amdgcn_readfirstlane(p_[1]); (const GAS float*)(((unsigned long long)hi_ << 32) | lo_); })
__device__ __forceinline__ void tr_block(const float* colp, float cs, const float* kg, int ldw, int K, bf16* WT, int d0, int k0, LAS float* scr, int lane) {
    float tv[32];
#pragma unroll
    for (int i = 0; i < 32; ++i) { const int kk = 2 * i + (lane >> 5); tv[i] = colp ? __builtin_nontemporal_load((const GAS float*)colp + (size_t)(k0 + kk) * ldw) : 0.f; }
#pragma unroll
    for (int i = 0; i < 32; ++i) { const int kk = 2 * i + (lane >> 5); scr[kk * 33 + (lane & 31)] = tv[i] * cs; }
    asm volatile("s_waitcnt lgkmcnt(0)" ::: "memory");
    const int c = lane & 7;
    f32x4 g0 = {1.f, 1.f, 1.f, 1.f}, g1 = {1.f, 1.f, 1.f, 1.f};
    if (kg) { g0 = *(const GAS f32x4*)(kg + k0 + 8 * c); g1 = *(const GAS f32x4*)(kg + k0 + 8 * c + 4); }
#pragma unroll
    for (int j = 0; j < 4; ++j) { const int n = (lane >> 3) + 8 * j; const LAS float* s = scr + (8 * c) * 33 + n;
        u32x4 o; o.x = pk2(s[0 * 33] * g0[0], s[1 * 33] * g0[1]); o.y = pk2(s[2 * 33] * g0[2], s[3 * 33] * g0[3]); o.z = pk2(s[4 * 33] * g1[0], s[5 * 33] * g1[1]); o.w = pk2(s[6 * 33] * g1[2], s[7 * 33] * g1[3]);
        *(GAS u32x4*)(WT + (size_t)(d0 + n) * K + k0 + 8 * c) = o; }
    asm volatile("s_waitcnt lgkmcnt(0)" ::: "memory");
}
__device__ __forceinline__ void p0_prologue(const Args& a, LAS unsigned char* lds, int vb, int G, int wave, int lane) {
    LAS float* scr = (LAS float*)(lds + wave * 16384);
    const int gw = vb * 8 + wave, NGW = G * 8;
    unsigned char* ws = a.ws;
    constexpr int I_GU = 16 * 176, I_D = 44 * 32, I_IN = 16 * 120, I_SQ = 16 * 32, I_UV = 32;
    constexpr int NITEMS = 2 * I_GU + 2 * I_D + I_IN + 5 * I_SQ + I_UV;
    for (int item = gw; item < NITEMS; item += NGW) {
        int it = item; const int l32 = lane & 31;
        if (it < 2 * I_GU) { const int l = it / I_GU; it %= I_GU; const int kb = it / 176, nb = it % 176, d = nb * 32 + l32, blk = d >> 8, w = d & 255;
            const float* wg = l ? a.f2wg : a.f1wg; const float* wu = l ? a.f2wu : a.f1wu;
            const float* src = (w < 128) ? wg + (blk * 128 + w) : wu + (blk * 128 + (w - 128));
            tr_block(src, 1.f, l ? a.f2g : a.f1g, FF, DM, (bf16*)(ws + (l ? WS_WGU2 : WS_WGU1)), nb * 32, kb * 64, scr, lane); continue; }
        it -= 2 * I_GU;
        if (it < 2 * I_D) { const int l = it / I_D; it %= I_D; const int kb = it / 32, nb = it % 32;
            tr_block((l ? a.f2wd : a.f1wd) + nb * 32 + l32, 1.f, nullptr, DM, FF, (bf16*)(ws + (l ? WS_WD2 : WS_WD1)), nb * 32, kb * 64, scr, lane); continue; }
        it -= 2 * I_D;
        if (it < I_IN) { const int kb = it / 120, nb = it % 120, d = nb * 32 + l32; int sc; float cs = 1.f;
            if (d < 1536) sc = d; else if (d < 2048) sc = d - 1536 + 1544;
            else if (d < 3072) { sc = d - 2048 + 2056; cs = a.kvg[(d - 2048) & 127] * (0.08838834764831845f * LOG2E); }
            else if (d < 3200) sc = d - 3072 + 3080;
            else if (d < 3712) { sc = d - 3200 + 3208; cs = a.idxg[(d - 3200) & 63]; }
            else if (d < 3776) sc = d - 3712 + 3720; else if (d < 3784) sc = d - 3776 + 1536; else if (d < 3792) sc = d; else sc = -1;
            tr_block(sc >= 0 ? a.win + sc : nullptr, cs, a.mixg, 3792, DM, (bf16*)(ws + WS_WIN), nb * 32, kb * 64, scr, lane); continue; }
        it -= I_IN;
        if (it < 5 * I_SQ) { const int which = it / I_SQ; it %= I_SQ; const int kb = it / 32, nb = it % 32, n = nb * 32 + l32;
            if (which == 0) tr_block(a.wout + n, 1.f, nullptr, DM, DM, (bf16*)(ws + WS_WOUT), nb * 32, kb * 64, scr, lane);
            else if (which == 1) tr_block(a.xwq + n, 0.0625f * LOG2E, a.xag, DM, DM, (bf16*)(ws + WS_WQ), nb * 32, kb * 64, scr, lane);
            else if (which == 2) tr_block(a.xwkv + n, 1.f, a.memg, 2 * DM, DM, (bf16*)(ws + WS_WK), nb * 32, kb * 64, scr, lane);
            else if (which == 3) tr_block(a.xwkv + DM + n, 1.f, a.memg, 2 * DM, DM, (bf16*)(ws + WS_WV), nb * 32, kb * 64, scr, lane);
            else tr_block(a.xwo + n, 1.f, nullptr, DM, DM, (bf16*)(ws + WS_WO), nb * 32, kb * 64, scr, lane);
            continue; }
        it -= 5 * I_SQ;
        { const int hh = it >> 2, kb = (it >> 1) & 1, nb = it & 1;
            tr_block(a.wuv + (size_t)hh * 128 * 64 + nb * 32 + l32, 1.f, a.kvg, 64, 128, (bf16*)(ws + WS_WUV), hh * 64 + nb * 32, kb * 64, scr, lane); }
    }
    for (int m0 = 2 * gw; m0 < NT + MEMR; m0 += 2 * NGW) {
        f32x4 v[2][4];
#pragma unroll
        for (int rr = 0; rr < 2; ++rr) { const int m = m0 + rr; const bool isx = m < NT; const int r = isx ? m : m - NT;
            const GAS f32x4* xr = (const GAS f32x4*)((isx ? a.x : a.mem) + (size_t)r * DM) + lane;
#pragma unroll
            for (int j = 0; j < 4; ++j) v[rr][j] = __builtin_nontemporal_load(&xr[64 * j]); }
#pragma unroll
        for (int rr = 0; rr < 2; ++rr) { const int m = m0 + rr; const bool isx = m < NT; const int r = isx ? m : m - NT; float s = 0.f;
#pragma unroll
            for (int j = 0; j < 4; ++j) s += (v[rr][j][0] * v[rr][j][0] + v[rr][j][1] * v[rr][j][1]) + (v[rr][j][2] * v[rr][j][2] + v[rr][j][3] * v[rr][j][3]);
            s = wave_sum(s);
            GAS u32x2* o8 = (GAS u32x2*)((GAS bf16*)(ws + (isx ? WS_XB : WS_MEMB)) + (size_t)r * DM) + lane;
#pragma unroll
            for (int j = 0; j < 4; ++j) { u32x2 w; w.x = pk2(v[rr][j][0], v[rr][j][1]); w.y = pk2(v[rr][j][2], v[rr][j][3]); o8[64 * j] = w; }
            if (isx) { if (lane < 16) ((GAS float*)(ws + WS_PARTX))[(size_t)r * 16 + lane] = lane == 0 ? s : 0.f; }
            else if (lane == 0) ((GAS float*)(ws + WS_RSTDMEM))[r] = rsqrtf(s * (1.f / 1024.f) + EPS); }
    }
}

__device__ __forceinline__ void prep_unit(const Args& a, LAS unsigned char* lds, int b, int kt, int tid) {
    const GAS bf16* z = (const GAS bf16*)(a.ws + WS_Z);
    LAS bf16* tT = (LAS bf16*)lds;
    const int key = tid >> 3, ch = tid & 7; const size_t row = (size_t)b * SEQ + kt * 64 + key;
    const u32x4 d0 = *(const GAS u32x4*)(z + row * ZW + ZDC + 16 * ch), d1 = *(const GAS u32x4*)(z + row * ZW + ZDC + 16 * ch + 8);
    const u32x4 k0 = *(const GAS u32x4*)(z + row * ZW + ZIK + 8 * ch);
    float v[16]; float ss = 0.f;
#pragma unroll
    for (int i = 0; i < 4; ++i) { v[2 * i] = bflo(d0[i]); v[2 * i + 1] = bfhi(d0[i]); v[8 + 2 * i] = bflo(d1[i]); v[8 + 2 * i + 1] = bfhi(d1[i]); }
#pragma unroll
    for (int i = 0; i < 16; ++i) ss += v[i] * v[i];
    ss += __shfl_xor(ss, 1); ss += __shfl_xor(ss, 2); ss += __shfl_xor(ss, 4);
    const float r = rsqrtf(ss * (1.f / 128.f) + EPS);
    unsigned short o[16];
    u32x4 w0, w1;
#pragma unroll
    for (int i = 0; i < 4; ++i) { w0[i] = pk2(v[2 * i] * r, v[2 * i + 1] * r); w1[i] = pk2(v[8 + 2 * i] * r, v[8 + 2 * i + 1] * r);
        o[2 * i] = (unsigned short)(w0[i] & 0xffffu); o[2 * i + 1] = (unsigned short)(w0[i] >> 16); o[8 + 2 * i] = (unsigned short)(w1[i] & 0xffffu); o[8 + 2 * i + 1] = (unsigned short)(w1[i] >> 16); }
    GAS bf16* ckv = (GAS bf16*)(a.ws + WS_CKV);
    *(GAS u32x4*)(ckv + row * 128 + 16 * ch) = w0; *(GAS u32x4*)(ckv + row * 128 + 16 * ch + 8) = w1;
#pragma unroll
    for (int i = 0; i < 16; ++i) tT[(16 * ch + i) * 72 + key] = o[i];
    float kv[8]; float s2 = 0.f;
#pragma unroll
    for (int i = 0; i < 4; ++i) { kv[2 * i] = bflo(k0[i]); kv[2 * i + 1] = bfhi(k0[i]); }
#pragma unroll
    for (int i = 0; i < 8; ++i) s2 += kv[i] * kv[i];
    s2 += __shfl_xor(s2, 1); s2 += __shfl_xor(s2, 2); s2 += __shfl_xor(s2, 4);
    const float r2 = rsqrtf(s2 * (1.f / 64.f) + EPS);
    u32x4 wk;
#pragma unroll
    for (int i = 0; i < 4; ++i) wk[i] = pk2(kv[2 * i] * r2, kv[2 * i + 1] * r2);
    *(GAS u32x4*)((GAS bf16*)(a.ws + WS_IKN) + row * 64 + 8 * ch) = wk;
    __syncthreads();
    const int c = tid >> 2, q4 = tid & 3;
    const u32x4 t0 = *(const LAS u32x4*)(tT + c * 72 + 16 * q4), t1 = *(const LAS u32x4*)(tT + c * 72 + 16 * q4 + 8);
    GAS bf16* dst = (GAS bf16*)(a.ws + WS_CKVT) + ((size_t)b * 128 + c) * SEQ + kt * 64 + 16 * q4;
    *(GAS u32x4*)dst = t0; *(GAS u32x4*)(dst + 8) = t1;
    __syncthreads();
}
__device__ __forceinline__ void indexer_unit(const Args& a, LAS unsigned char* lds, LAS unsigned long long* maskl, int b, int qblk, int wave, int lane) {
    LAS float* sc = (LAS float*)lds;
    const GAS bf16* z = (const GAS bf16*)(a.ws + WS_Z); const GAS bf16* ikn = (const GAS bf16*)(a.ws + WS_IKN);
    const int fr = lane & 15, fq = lane >> 4, t0 = qblk * 16; const size_t rowb = (size_t)b * SEQ;
    bf16x8 af[8][2]; float wv[8][4];
#pragma unroll
    for (int rt = 0; rt < 8; ++rt) {
        const GAS bf16* p = z + (rowb + t0 + 2 * rt + (fr >> 3)) * ZW + ZIQ + (fr & 7) * 64 + 8 * fq;
        af[rt][0] = __builtin_nontemporal_load((const GAS bf16x8*)p); af[rt][1] = __builtin_nontemporal_load((const GAS bf16x8*)(p + 32));
        const u32x2 w = *(const GAS u32x2*)(z + (rowb + t0 + 2 * rt + (fq >> 1)) * ZW + ZIW + 4 * (fq & 1));
        wv[rt][0] = bflo(w.x); wv[rt][1] = bfhi(w.x); wv[rt][2] = bflo(w.y); wv[rt][3] = bfhi(w.y);
    }
    const int nkt = qblk + 1;
    bf16x8 nb0, nb1;
    { const int k0 = wave < nkt ? wave : 0; const GAS bf16* p = ikn + (rowb + 16 * k0 + fr) * 64 + 8 * fq; nb0 = *(const GAS bf16x8*)p; nb1 = *(const GAS bf16x8*)(p + 32); }
    for (int kt = wave; kt < nkt; kt += 8) {
        const int key = 16 * kt + fr;
        const bf16x8 b0 = nb0, b1 = nb1;
        { const int k2 = kt + 8 < nkt ? kt + 8 : kt; const GAS bf16* p = ikn + (rowb + 16 * k2 + fr) * 64 + 8 * fq; nb0 = *(const GAS bf16x8*)p; nb1 = *(const GAS bf16x8*)(p + 32); }
#pragma unroll
        for (int rt = 0; rt < 8; ++rt) {
            f32x4 acc = {0.f, 0.f, 0.f, 0.f};
            acc = mfma16(af[rt][0], b0, acc); acc = mfma16(af[rt][1], b1, acc);
            float part = wv[rt][0] * fmaxf(acc[0], 0.f) + wv[rt][1] * fmaxf(acc[1], 0.f) + wv[rt][2] * fmaxf(acc[2], 0.f) + wv[rt][3] * fmaxf(acc[3], 0.f);
            part += __shfl_xor(part, 16); part += 0.f;
            if ((fq & 1) == 0) sc[(2 * rt + (fq >> 1)) * 2048 + key] = part;
        }
    }
    __syncthreads();
#pragma unroll 1
    for (int qq = 0; qq < 2; ++qq) {
        const int q = 2 * wave + qq, t = t0 + q, n = t + 1;
        unsigned long long myword = 0ull;
        if (n <= 256) {
            const int lo = 64 * lane;
            myword = (n >= lo + 64) ? ~0ull : (n > lo ? ((1ull << (n - lo)) - 1ull) : 0ull);
        } else {
            const int nr = __builtin_amdgcn_readfirstlane((n + 63) >> 6);
            unsigned u[32];
#pragma unroll
            for (int r = 0; r < 32; ++r) u[r] = 0u;
#pragma unroll
            for (int g = 0; g < 8; ++g) if (4 * g < nr) {
#pragma unroll
                for (int k4 = 0; k4 < 4; ++k4) { const int r = 4 * g + k4; const int idx = 64 * r + lane; const unsigned bits = __builtin_bit_cast(unsigned, sc[q * 2048 + idx]);
                    const unsigned k = bits ^ (((unsigned)((int)bits >> 31)) | 0x80000000u); u[r] = idx < n ? k : 0u; } }
            unsigned T = 0u; bool exact = false; const int ng = (nr + 3) >> 2;
#pragma unroll 1
            for (int bit = 31; bit >= 0; --bit) {
                const unsigned cand = T | (1u << bit); int cnt = 0;
#define TK_GRP(g) { const int c0 = __popcll(__ballot(u[4 * (g)] >= cand)), c1 = __popcll(__ballot(u[4 * (g) + 1] >= cand)), c2 = __popcll(__ballot(u[4 * (g) + 2] >= cand)), c3 = __popcll(__ballot(u[4 * (g) + 3] >= cand)); cnt += (c0 + c1) + (c2 + c3); }
                switch (ng) {
                    case 8: TK_GRP(7) [[fallthrough]];
                    case 7: TK_GRP(6) [[fallthrough]];
                    case 6: TK_GRP(5) [[fallthrough]];
                    case 5: TK_GRP(4) [[fallthrough]];
                    case 4: TK_GRP(3) [[fallthrough]];
                    case 3: TK_GRP(2) [[fallthrough]];
                    case 2: TK_GRP(1) [[fallthrough]];
                    default: TK_GRP(0)
                }
#undef TK_GRP
                if (cnt >= 256) { T = cand; if (cnt == 256) { exact = true; break; } }
            }
            int need = 0; const unsigned long long lt = (1ull << lane) - 1ull;
            if (!exact) {
                int cl = 0;
#pragma unroll
                for (int r = 0; r < 32; ++r) cl += (u[r] > T) ? 1 : 0;
                int ngt = 0;
#pragma unroll
                for (int bb = 0; bb < 6; ++bb) ngt += __popcll(__ballot((cl >> bb) & 1)) << bb;
                need = 256 - ngt;
            }
#pragma unroll
            for (int g = 0; g < 8; ++g) if (4 * g < nr) {
#pragma unroll
                for (int k = 0; k < 4; ++k) { const int r = 4 * g + k;
                    unsigned ur = u[r]; asm volatile("" : "+v"(ur), "+v"(myword), "+s"(need));
                    unsigned long long m;
                    if (exact) m = __ballot(ur >= T);
                    else { const unsigned long long eq = __ballot(ur == T), gt = __ballot(ur > T);
                        const bool pick = (ur == T) && (__popcll(eq & lt) < need);
                        m = gt | __ballot(pick); need -= __popcll(eq); if (need < 0) need = 0; }
                    if (lane == r) myword = m; } }
        }
        if (lane < 32) maskl[q * 32 + lane] = myword;
    }
    __syncthreads();
}

#define LDS_BARRIER() do { asm volatile("s_waitcnt lgkmcnt(0)" ::: "memory"); __builtin_amdgcn_s_barrier(); asm volatile("" ::: "memory"); } while (0)
__device__ __forceinline__ float rdlane(float v, int l) { return __builtin_bit_cast(float, __builtin_amdgcn_readlane(__builtin_bit_cast(int, v), l)); }
__device__ __forceinline__ float scan_add(float v, int lane) {
#pragma unroll
    for (int o = 1; o < 64; o <<= 1) { const float t = __shfl_up(v, o); if (lane >= o) v += t; }
    return v;
}
__device__ __forceinline__ float scan_max(float v, int lane) {
#pragma unroll
    for (int o = 1; o < 64; o <<= 1) { const float t = __shfl_up(v, o); if (lane >= o) v = fmaxf(v, t); }
    return v;
}
__device__ __forceinline__ void mlstm_unit(const Args& a, LAS unsigned char* lds, int b, int h, int tid_in, int wave, int lane_in) {
    int tid = tid_in; asm volatile("" : "+v"(tid)); const int lane0 = tid & 63;
    constexpr int QS = 136, TS = 72, NS = 132;
    LAS bf16* q_s = (LAS bf16*)lds;
    LAS bf16* k_s = (LAS bf16*)(lds + 17408);
    LAS float* numS = (LAS float*)lds;
    LAS bf16* kTw = (LAS bf16*)(lds + 34816);
    LAS bf16* vT = (LAS bf16*)(lds + 53248);
    LAS bf16* P_s = (LAS bf16*)(lds + 73984);
    LAS bf16* C_s = (LAS bf16*)(lds + 83200);
    LAS float* gate = (LAS float*)(lds + 122368);
    LAS float* cw_s = (LAS float*)(lds + 124416);
    const GAS bf16* z = (const GAS bf16*)(a.ws + WS_Z); GAS bf16* Y = (GAS bf16*)(a.ws + WS_Y);
    const size_t rowb = (size_t)b * SEQ;
    for (int i = tid; i < 144 * 136 / 2; i += 512) ((LAS unsigned*)C_s)[i] = 0u;
    for (int i = tid; i < 16 * 72; i += 512) vT[128 * 72 + i] = (i < 64) ? (bf16)0x3f80 : (bf16)0;
    LAS float* hg_s = (LAS float*)(lds + 129536);
    float ib, fb;
    { const GAS float* convw = LDPTR(1); const GAS float* convb = LDPTR(2); const GAS float* hgp = LDPTR(5);
      for (int i = tid; i < 5 * 256; i += 512) { const int j = i >> 8, c = i & 255, col = (c < 128 ? h * 128 + c : 512 + h * 128 + (c - 128)); cw_s[i] = j < 4 ? convw[j * 1024 + col] : convb[col]; }
      if (tid < 128) hg_s[tid] = hgp[h * 128 + tid];
      ib = LDPTR(3)[h]; fb = LDPTR(4)[h]; }
    f32x4 Creg[9];
#pragma unroll
    for (int e = 0; e < 9; ++e) Creg[e] = (f32x4){0.f, 0.f, 0.f, 0.f};
    float mstate = 0.f;
    const int sel = tid >> 8, cgp = tid & 15, rg = (tid >> 4) & 15;
    const int colbase = (sel ? ZK : ZQ) + h * 128 + 8 * cgp;
    u32x4 raw[7], rawv[4]; unsigned short gmi, gmf; u32x4 ow2[2];
    const GAS char* zb = (const GAS char*)z;
    const unsigned vo_qk = (unsigned)((4 * rg) * ZW + colbase) * 2u, vo_v = (unsigned)((4 * rg) * ZW + ZV + h * 128 + 8 * cgp) * 2u;
    const unsigned vo_y = (unsigned)((8 * wave + (lane0 >> 3)) * DM + h * 128 + 16 * (lane0 & 7)) * 2u;
    const unsigned vo_g = (unsigned)(lane0 * ZW + ZMI + h) * 2u, vo_o = (unsigned)((8 * wave + (lane0 >> 3)) * ZW + ZO + h * 128 + 16 * (lane0 & 7)) * 2u;
#define ML_LOAD(cc) do { const int t0_ = 64 * (cc); const GAS char* zc_ = zb + (size_t)(rowb + t0_) * (ZW * 2); const GAS char* zc3_ = zc_ - 3 * (ZW * 2); \
        _Pragma("unroll") for (int jj = 0; jj < 7; ++jj) { const int tt = t0_ + 4 * rg - 3 + jj; raw[jj] = (u32x4){0u, 0u, 0u, 0u}; if (tt >= 0) raw[jj] = __builtin_nontemporal_load((const GAS u32x4*)(zc3_ + (size_t)(vo_qk + (unsigned)(jj * ZW * 2)))); } \
        if (sel == 0) { _Pragma("unroll") for (int i = 0; i < 4; ++i) rawv[i] = __builtin_nontemporal_load((const GAS u32x4*)(zc_ + (size_t)(vo_v + (unsigned)(i * ZW * 2)))); } \
        gmi = *(const GAS unsigned short*)(zc_ + (size_t)vo_g); gmf = *(const GAS unsigned short*)(zc_ + (size_t)(vo_g + 8u)); } while (0)
    LAS float* wgx = (LAS float*)(lds + 131072 + 256);
    ML_LOAD(0);
    float bc, av, pm;
    { const float mi = bf2f(gmi) + ib, mf = bf2f(gmf) + fb; const float lf = fminf(mf, 0.f) - __logf(1.f + __expf(-fabsf(mf)));
      bc = scan_add(lf, lane0); av = mi - bc; pm = scan_max(av, lane0); }
    __syncthreads();
#pragma unroll 1
    for (int c = 0; c < 32; ++c) {
        const int t0 = 64 * c, par = c & 1;
        int lane_i = lane0; asm volatile("" : "+v"(lane_i));
        const int lane = lane_i, fr = lane & 15, fq = lane >> 4;
        const float Mj = fmaxf(mstate, pm), M63 = rdlane(Mj, 63), bL = rdlane(bc, 63);
        const float wg = __expf(av - M63);
        if (wave == 0) { gate[par * 192 + lane] = Mj; gate[par * 192 + 64 + lane] = bc; gate[par * 192 + 128 + lane] = av; }
        wgx[wave * 64 + lane] = wg;
        asm volatile("s_waitcnt lgkmcnt(0)" ::: "memory");
        const f32x4 wgq = *(const LAS f32x4*)(wgx + wave * 64 + 4 * rg);
        const float wgv[4] = {wgq[0], wgq[1], wgq[2], wgq[3]};
        {
            float y[4][8];
#pragma unroll
            for (int e = 0; e < 8; ++e) {
                const int cc = sel * 128 + 8 * cgp + e;
                const float w0 = cw_s[cc], w1 = cw_s[256 + cc], w2 = cw_s[512 + cc], w3 = cw_s[768 + cc], bb = cw_s[1024 + cc];
                float xr[7];
#pragma unroll
                for (int jj = 0; jj < 7; ++jj) { const unsigned w = raw[jj][e >> 1]; xr[jj] = (e & 1) ? bfhi(w) : bflo(w); }
#pragma unroll
                for (int i = 0; i < 4; ++i) { const float xx = bb + w0 * xr[i] + w1 * xr[i + 1] + w2 * xr[i + 2] + w3 * xr[i + 3];
                    float s = xx * __builtin_amdgcn_rcpf(1.f + __expf(-xx)); if (sel) s *= 0.08838834764831845f; y[i][e] = s; }
            }
            LAS bf16* dst = sel ? k_s : q_s;
#pragma unroll
            for (int i = 0; i < 4; ++i) { u32x4 w; w.x = pk2(y[i][0], y[i][1]); w.y = pk2(y[i][2], y[i][3]); w.z = pk2(y[i][4], y[i][5]); w.w = pk2(y[i][6], y[i][7]);
                *(LAS u32x4*)(dst + (4 * rg + i) * QS + 8 * cgp) = w; }
            if (sel) {
#pragma unroll
                for (int e = 0; e < 8; ++e) { u32x2 w; w.x = pk2(y[0][e] * wgv[0], y[1][e] * wgv[1]); w.y = pk2(y[2][e] * wgv[2], y[3][e] * wgv[3]); *(LAS u32x2*)(kTw + (8 * cgp + e) * TS + 8 * ((rg >> 1) ^ ((cgp >> 1) & 7)) + 4 * (rg & 1)) = w; }
            } else {
#pragma unroll
                for (int e = 0; e < 8; ++e) { unsigned short v0 = (e & 1) ? (unsigned short)(rawv[0][e >> 1] >> 16) : (unsigned short)(rawv[0][e >> 1] & 0xffffu);
                    unsigned short v1 = (e & 1) ? (unsigned short)(rawv[1][e >> 1] >> 16) : (unsigned short)(rawv[1][e >> 1] & 0xffffu);
                    unsigned short v2 = (e & 1) ? (unsigned short)(rawv[2][e >> 1] >> 16) : (unsigned short)(rawv[2][e >> 1] & 0xffffu);
                    unsigned short v3 = (e & 1) ? (unsigned short)(rawv[3][e >> 1] >> 16) : (unsigned short)(rawv[3][e >> 1] & 0xffffu);
                    u32x2 w; w.x = v0 | ((unsigned)v1 << 16); w.y = v2 | ((unsigned)v3 << 16); *(LAS u32x2*)(vT + (8 * cgp + e) * TS + 8 * ((rg >> 1) ^ ((cgp >> 1) & 7)) + 4 * (rg & 1)) = w; }
            }
        }
        if (c + 1 < 32) ML_LOAD(c + 1);
        { const GAS char* zc_ = zb + (size_t)(rowb + t0) * (ZW * 2); ow2[0] = __builtin_nontemporal_load((const GAS u32x4*)(zc_ + (size_t)vo_o)); ow2[1] = __builtin_nontemporal_load((const GAS u32x4*)(zc_ + (size_t)(vo_o + 16u))); }
        LDS_BARRIER();
        {
            const int jt = wave >> 1;
#pragma unroll
            for (int s2 = 0; s2 < 2; ++s2) {
                const int st = 2 * (wave & 1) + s2;
                f32x4 acc = {0.f, 0.f, 0.f, 0.f};
                if (st <= jt) {
#pragma unroll
                    for (int kk = 0; kk < 4; ++kk) acc = mfma16(*(const LAS bf16x8*)(q_s + (16 * jt + fr) * QS + 32 * kk + 8 * fq), *(const LAS bf16x8*)(k_s + (16 * st + fr) * QS + 32 * kk + 8 * fq), acc);
                }
                const int s = 16 * st + fr; const float as = gate[par * 192 + 128 + s];
                float pv4[4];
#pragma unroll
                for (int i = 0; i < 4; ++i) { const int j = 16 * jt + 4 * fq + i; pv4[i] = (s <= j) ? acc[i] * __expf(as - gate[par * 192 + j]) : 0.f; }
                { const unsigned w0 = pk2(pv4[0], pv4[1]), w1 = pk2(pv4[2], pv4[3]); const int j0 = 16 * jt + 4 * fq;
                  P_s[(j0 + 0) * TS + s] = (bf16)(w0 & 0xffffu); P_s[(j0 + 1) * TS + s] = (bf16)(w0 >> 16); P_s[(j0 + 2) * TS + s] = (bf16)(w1 & 0xffffu); P_s[(j0 + 3) * TS + s] = (bf16)(w1 >> 16); }
            }
        }
        const int jt2 = wave & 3, etb = 4 * (wave >> 2);
        f32x4 hacc[5];
#pragma unroll
        for (int x = 0; x < 5; ++x) {
            hacc[x] = (f32x4){0.f, 0.f, 0.f, 0.f};
            const int et = x < 4 ? etb + x : 8;
            if (x & 1) asm volatile("" ::: "memory");
            if (x < 4 || wave < 4) {
#pragma unroll
                for (int kk = 0; kk < 4; ++kk) hacc[x] = mfma16(*(const LAS bf16x8*)(q_s + (16 * jt2 + fr) * QS + 32 * kk + 8 * fq), *(const LAS bf16x8*)(C_s + (16 * et + fr) * QS + 32 * kk + 8 * fq), hacc[x]);
            }
        }
        {
            float sc4[4];
#pragma unroll
            for (int i = 0; i < 4; ++i) sc4[i] = __expf(mstate - gate[par * 192 + 16 * jt2 + 4 * fq + i]);
#pragma unroll
            for (int x = 0; x < 5; ++x)
#pragma unroll
                for (int i = 0; i < 4; ++i) hacc[x][i] *= sc4[i];
        }
        LDS_BARRIER();
#pragma unroll
        for (int x = 0; x < 5; ++x) {
            const int et = x < 4 ? etb + x : 8;
            if (x & 1) asm volatile("" ::: "memory");
            if (x < 4 || wave < 4) {
#pragma unroll
                for (int kk = 0; kk < 2; ++kk) hacc[x] = mfma16(*(const LAS bf16x8*)(P_s + (16 * jt2 + fr) * TS + 32 * kk + 8 * fq), *(const LAS bf16x8*)(vT + (16 * et + fr) * TS + 8 * ((4 * kk + fq) ^ (et & 7))), hacc[x]);
#pragma unroll
                for (int i = 0; i < 4; ++i) { const int e = 16 * et + fr; if (e < 129) numS[(16 * jt2 + 4 * fq + i) * NS + e] = hacc[x][i]; }
            }
        }
        {
            const float dec = __expf(mstate - M63);
#pragma unroll
            for (int et = 0; et < 9; ++et) {
                if ((et & 1) == 0) asm volatile("" ::: "memory");
                Creg[et] = Creg[et] * dec;
#pragma unroll
                for (int kk = 0; kk < 2; ++kk) Creg[et] = mfma16(*(const LAS bf16x8*)(vT + (16 * et + fr) * TS + 8 * ((4 * kk + fq) ^ (et & 7))), *(const LAS bf16x8*)(kTw + (16 * wave + fr) * TS + 8 * ((4 * kk + fq) ^ (wave & 7))), Creg[et]);
                { const unsigned w0 = pk2(Creg[et][0], Creg[et][1]), w1 = pk2(Creg[et][2], Creg[et][3]); const int e0 = 16 * et + 4 * fq, dcol = 16 * wave + fr;
                  C_s[(e0 + 0) * QS + dcol] = (bf16)(w0 & 0xffffu); C_s[(e0 + 1) * QS + dcol] = (bf16)(w0 >> 16); C_s[(e0 + 2) * QS + dcol] = (bf16)(w1 & 0xffffu); C_s[(e0 + 3) * QS + dcol] = (bf16)(w1 >> 16); }
            }
        }
        LDS_BARRIER();
        {
            const int jr = lane >> 3, ec = lane & 7, j = 8 * wave + jr;
            f32x4 nv[4], gv[4];
#pragma unroll
            for (int k = 0; k < 4; ++k) { nv[k] = *(const LAS f32x4*)(numS + j * NS + 16 * ec + 4 * k); gv[k] = *(const LAS f32x4*)(hg_s + 16 * ec + 4 * k); }
            const float den = numS[j * NS + 128];
            const float dn = fmaxf(fabsf(den), __expf(-(gate[par * 192 + 64 + j] + gate[par * 192 + j])));
            const float idn = __builtin_amdgcn_rcpf(dn); float ss = 0.f;
#pragma unroll
            for (int k = 0; k < 4; ++k) { nv[k] = nv[k] * idn; ss += (nv[k][0] * nv[k][0] + nv[k][1] * nv[k][1]) + (nv[k][2] * nv[k][2] + nv[k][3] * nv[k][3]); }
            ss += __shfl_xor(ss, 1); ss += __shfl_xor(ss, 2); ss += __shfl_xor(ss, 4);
            const float rs = rsqrtf(ss * (1.f / 128.f) + EPS);
            u32x4 yo[2];
#pragma unroll
            for (int k = 0; k < 4; ++k) {
                const unsigned w0 = ow2[k >> 1][2 * (k & 1)], w1 = ow2[k >> 1][2 * (k & 1) + 1];
                const float o0 = bflo(w0), o1 = bfhi(w0), o2 = bflo(w1), o3 = bfhi(w1);
                const float y0 = nv[k][0] * rs * gv[k][0] * __builtin_amdgcn_rcpf(1.f + __expf(-o0)), y1 = nv[k][1] * rs * gv[k][1] * __builtin_amdgcn_rcpf(1.f + __expf(-o1));
                const float y2 = nv[k][2] * rs * gv[k][2] * __builtin_amdgcn_rcpf(1.f + __expf(-o2)), y3 = nv[k][3] * rs * gv[k][3] * __builtin_amdgcn_rcpf(1.f + __expf(-o3));
                yo[k >> 1][2 * (k & 1)] = pk2(y0, y1); yo[k >> 1][2 * (k & 1) + 1] = pk2(y2, y3);
            }
            GAS char* yp = (GAS char*)Y + (size_t)(rowb + t0) * (DM * 2) + (size_t)vo_y;
            *(GAS u32x4*)yp = yo[0]; *(GAS u32x4*)(yp + 16) = yo[1];
        }
        mstate = bL + M63;
        if (c + 1 < 32) {
            const float mi = bf2f(gmi) + ib, mf = bf2f(gmf) + fb; const float lf = fminf(mf, 0.f) - __logf(1.f + __expf(-fabsf(mf)));
            bc = scan_add(lf, lane); av = mi - bc; pm = scan_max(av, lane); }
        LDS_BARRIER();
    }
}
typedef float f32x16 __attribute__((ext_vector_type(16)));
__device__ __forceinline__ f32x16 mfma32(bf16x8 a, bf16x8 b, f32x16 c) { return __builtin_amdgcn_mfma_f32_32x32x16_bf16(a, b, c, 0, 0, 0); }
__device__ __forceinline__ void dsa_unit32(const Args& a, LAS unsigned char* lds, const LAS unsigned long long* maskl, int b, int qb, int tid, int wave, int lane) {
    constexpr int KS = 136, VS = 76, KBYTES = 64 * KS * 2, STG = KBYTES + 128 * VS * 2;
    const GAS bf16* z = (const GAS bf16*)(a.ws + WS_Z); const GAS bf16* ckv = (const GAS bf16*)(a.ws + WS_CKV); const GAS bf16* ckvT = (const GAS bf16*)(a.ws + WS_CKVT);
    const GAS bf16* wuv = (const GAS bf16*)(a.ws + WS_WUV); GAS bf16* Y = (GAS bf16*)(a.ws + WS_Y);
    const int l31 = lane & 31, hi = lane >> 5, t0 = qb * 32, h = wave; const size_t rowb = (size_t)b * SEQ;
    bf16x8 qf[8]; float qs = 0.f;
#pragma unroll
    for (int ks = 0; ks < 8; ++ks) { const u32x4 w = __builtin_nontemporal_load((const GAS u32x4*)(z + (rowb + t0 + l31) * ZW + ZDQ + h * 128 + 16 * ks + 8 * hi)); qf[ks] = __builtin_bit_cast(bf16x8, w);
#pragma unroll
        for (int i = 0; i < 4; ++i) { const float x0 = bflo(w[i]), x1 = bfhi(w[i]); qs += x0 * x0 + x1 * x1; } }
    qs += __shfl_xor(qs, 32);
    const float negB = -1.01f * 11.313708498984761f * sqrtf(qs);
    const int nkt = (t0 + 32 + 63) >> 6;
    f32x16 O[4];
#pragma unroll
    for (int ct = 0; ct < 4; ++ct)
#pragma unroll
        for (int i = 0; i < 16; ++i) O[ct][i] = 0.f;
    float l = 0.f;
    u32x4 rk0[2], rv0[2], rk1[2], rv1[2];
    const unsigned vok0 = (unsigned)((tid >> 4) * 128 + 8 * (tid & 15)) * 2u, vok1 = vok0 + 32u * 128u * 2u;
    const unsigned vov0 = (unsigned)((tid >> 3) * SEQ + 8 * (tid & 7)) * 2u, vov1 = vov0 + 64u * (unsigned)SEQ * 2u;
    const GAS char* ckb = (const GAS char*)ckv + (size_t)rowb * 256; const GAS char* cvb = (const GAS char*)ckvT + (size_t)b * 128 * SEQ * 2;
#define DSA_GLOAD(kt, RK, RV) do { const GAS char* kb_ = ckb + (size_t)(kt) * (64 * 256); const GAS char* vb_ = cvb + (size_t)(kt) * 128; \
        RK[0] = *(const GAS u32x4*)(kb_ + (size_t)vok0); RK[1] = *(const GAS u32x4*)(kb_ + (size_t)vok1); \
        RV[0] = *(const GAS u32x4*)(vb_ + (size_t)vov0); RV[1] = *(const GAS u32x4*)(vb_ + (size_t)vov1); } while (0)
#define DSA_LSTORE(buf, RK, RV) do { LAS bf16* Ks_ = (LAS bf16*)(lds + (buf) * STG); LAS bf16* Vs_ = (LAS bf16*)(lds + (buf) * STG + KBYTES); \
        _Pragma("unroll") for (int i = 0; i < 2; ++i) { const int id = tid + 512 * i; *(LAS u32x4*)(Ks_ + (id >> 4) * KS + 8 * (id & 15)) = RK[i]; \
            u32x2 lo_, hh_; lo_.x = RV[i].x; lo_.y = RV[i].y; hh_.x = RV[i].z; hh_.y = RV[i].w; \
            *(LAS u32x2*)(Vs_ + (id >> 3) * VS + 8 * (id & 7)) = lo_; *(LAS u32x2*)(Vs_ + (id >> 3) * VS + 8 * (id & 7) + 4) = hh_; } } while (0)
    auto compute = [&](int buf, int kt) {
        const unsigned long long mw = maskl[l31 * 32 + kt];
        const LAS bf16* Ks = (const LAS bf16*)(lds + buf * STG); const LAS bf16* Vs = (const LAS bf16*)(lds + buf * STG + KBYTES);
        f32x16 S2[2];
#pragma unroll
        for (int kh = 0; kh < 2; ++kh) {
#pragma unroll
            for (int i = 0; i < 16; ++i) S2[kh][i] = negB;
            __builtin_amdgcn_s_setprio(1);
#pragma unroll
            for (int ks = 0; ks < 8; ++ks) S2[kh] = mfma32(*(const LAS bf16x8*)(Ks + (32 * kh + l31) * KS + 16 * ks + 8 * hi), qf[ks], S2[kh]);
            __builtin_amdgcn_s_setprio(0);
        }
#pragma unroll
        for (int kh = 0; kh < 2; ++kh) {
            const unsigned mh = (unsigned)(mw >> (32 * kh + 4 * hi));
            float p[16];
#pragma unroll
            for (int i = 0; i < 16; ++i) { const float e = __builtin_amdgcn_exp2f(S2[kh][i]);
                const int keep = __builtin_amdgcn_sbfe((int)mh, 8 * (i >> 2) + (i & 3), 1);
                p[i] = __builtin_bit_cast(float, __builtin_bit_cast(int, e) & keep); l += p[i]; }
            u32x4 w0, w1;
            w0.x = pk2(p[0], p[1]); w0.y = pk2(p[2], p[3]); w0.z = pk2(p[4], p[5]); w0.w = pk2(p[6], p[7]);
            w1.x = pk2(p[8], p[9]); w1.y = pk2(p[10], p[11]); w1.z = pk2(p[12], p[13]); w1.w = pk2(p[14], p[15]);
            const bf16x8 pa = __builtin_bit_cast(bf16x8, w0), pb = __builtin_bit_cast(bf16x8, w1);
            __builtin_amdgcn_s_setprio(1);
#pragma unroll
            for (int ct = 0; ct < 4; ++ct) {
                const LAS bf16* vr = Vs + (32 * ct + l31) * VS + 4 * hi + 32 * kh;
                O[ct] = mfma32(cat8(*(const LAS u32x2*)(vr), *(const LAS u32x2*)(vr + 8)), pa, O[ct]);
                O[ct] = mfma32(cat8(*(const LAS u32x2*)(vr + 16), *(const LAS u32x2*)(vr + 24)), pb, O[ct]);
            }
            __builtin_amdgcn_s_setprio(0);
        }
    };
    DSA_GLOAD(0, rk0, rv0); if (nkt > 1) DSA_GLOAD(1, rk1, rv1);
    DSA_LSTORE(0, rk0, rv0);
    __syncthreads();
#pragma unroll 1
    for (int kt = 0; kt < nkt; kt += 2) {
        if (kt + 2 < nkt) DSA_GLOAD(kt + 2, rk0, rv0);
        compute(0, kt);
        if (kt + 1 < nkt) DSA_LSTORE(1, rk1, rv1);
        __syncthreads();
        if (kt + 1 >= nkt) break;
        if (kt + 3 < nkt) DSA_GLOAD(kt + 3, rk1, rv1);
        compute(1, kt + 1);
        if (kt + 2 < nkt) DSA_LSTORE(0, rk0, rv0);
        __syncthreads();
    }
#undef DSA_GLOAD
#undef DSA_LSTORE
    l += __shfl_xor(l, 32);
    const float il = 1.f / l;
    bf16x8 of[8];
#pragma unroll
    for (int ks = 0; ks < 8; ++ks) { const int ct = ks >> 1, o8 = 8 * (ks & 1); u32x4 w;
        w.x = pk2(O[ct][o8 + 0] * il, O[ct][o8 + 1] * il); w.y = pk2(O[ct][o8 + 2] * il, O[ct][o8 + 3] * il);
        w.z = pk2(O[ct][o8 + 4] * il, O[ct][o8 + 5] * il); w.w = pk2(O[ct][o8 + 6] * il, O[ct][o8 + 7] * il); of[ks] = __builtin_bit_cast(bf16x8, w); }
#pragma unroll
    for (int vt = 0; vt < 2; ++vt) {
        f32x16 acc;
#pragma unroll
        for (int i = 0; i < 16; ++i) acc[i] = 0.f;
        const GAS bf16* wr = wuv + (size_t)(h * 64 + 32 * vt + l31) * 128 + 4 * hi;
#pragma unroll
        for (int ks = 0; ks < 8; ++ks) acc = mfma32(cat8(*(const GAS u32x2*)(wr + 16 * ks), *(const GAS u32x2*)(wr + 16 * ks + 8)), of[ks], acc);
#pragma unroll
        for (int g = 0; g < 4; ++g) { u32x2 w; w.x = pk2(acc[4 * g], acc[4 * g + 1]); w.y = pk2(acc[4 * g + 2], acc[4 * g + 3]);
            *(GAS u32x2*)(Y + (rowb + t0 + l31) * DM + 512 + h * 64 + 32 * vt + 8 * g + 4 * hi) = w; }
    }
}

__device__ __forceinline__ void xattn_unit(const Args& a, LAS unsigned char* lds, int b, int h, int qb, int tid, int wave, int lane) {
    constexpr int KS = 264, VS = 72, STG = 36864;
    const GAS bf16* QX = (const GAS bf16*)(a.ws + WS_QX); const GAS bf16* KX = (const GAS bf16*)(a.ws + WS_KX); const GAS bf16* VTX = (const GAS bf16*)(a.ws + WS_VTX); GAS bf16* XO = (GAS bf16*)(a.ws + WS_XO);
    const int fr = lane & 15, fq = lane >> 4; const size_t qrow = (size_t)b * SEQ + qb * 128 + 16 * wave + fr;
    bf16x8 qf[8];
#pragma unroll
    for (int kk = 0; kk < 8; ++kk) qf[kk] = *(const GAS bf16x8*)(QX + qrow * DM + h * 256 + 32 * kk + 8 * fq);
    u32x4 rr[2][4];
    const unsigned vok = (unsigned)((tid >> 5) * DM + 8 * (tid & 31)) * 2u, vov = (unsigned)((tid >> 3) * MEMR + 8 * (tid & 7)) * 2u;
    const GAS char* kxb = (const GAS char*)KX + ((size_t)b * 256 * DM + h * 256) * 2; const GAS char* vxb = (const GAS char*)VTX + ((size_t)h * 256 * MEMR + b * 256) * 2;
    auto gload = [&](int j) {
        if (j < 4) { const GAS char* p_ = kxb + (size_t)j * (64 * DM * 2);
#pragma unroll
            for (int i = 0; i < 4; ++i) rr[j & 1][i] = *(const GAS u32x4*)(p_ + (size_t)(vok + (unsigned)(i * 16 * DM * 2)));
        } else { const GAS char* p_ = vxb + (size_t)(j - 4) * 128;
#pragma unroll
            for (int i = 0; i < 4; ++i) rr[j & 1][i] = *(const GAS u32x4*)(p_ + (size_t)(vov + (unsigned)(i * 64 * MEMR * 2)));
        }
    };
    auto lstore = [&](int j) {
        LAS bf16* base = (LAS bf16*)(lds + (j & 1) * STG);
        if (j < 4) {
#pragma unroll
            for (int i = 0; i < 4; ++i) { const int id = tid + 512 * i; *(LAS u32x4*)(base + (id >> 5) * KS + 8 * (id & 31)) = rr[j & 1][i]; }
        } else {
#pragma unroll
            for (int i = 0; i < 4; ++i) { const int id = tid + 512 * i; *(LAS u32x4*)(base + (id >> 3) * VS + 8 * (id & 7)) = rr[j & 1][i]; }
        }
    };
    f32x4 S[16]; bf16x8 pf[8]; f32x4 O[16]; float l = 0.f;
#pragma unroll
    for (int i = 0; i < 16; ++i) { S[i] = (f32x4){0.f, 0.f, 0.f, 0.f}; O[i] = (f32x4){0.f, 0.f, 0.f, 0.f}; }
    gload(0); gload(1); lstore(0); __syncthreads();
#pragma unroll
    for (int j = 0; j < 8; ++j) {
        if (j < 6) gload(j + 2);
        const LAS bf16* base = (const LAS bf16*)(lds + (j & 1) * STG);
        if (j < 4) {
#pragma unroll
            for (int rt = 0; rt < 4; ++rt)
#pragma unroll
                for (int kk = 0; kk < 8; ++kk) S[4 * j + rt] = mfma16(*(const LAS bf16x8*)(base + (16 * rt + fr) * KS + 32 * kk + 8 * fq), qf[kk], S[4 * j + rt]);
            if (j == 3) {
                float mx = -3.0e38f;
#pragma unroll
                for (int i = 0; i < 16; ++i) mx = fmaxf(mx, fmaxf(fmaxf(S[i][0], S[i][1]), fmaxf(S[i][2], S[i][3])));
                mx = fmaxf(mx, __shfl_xor(mx, 16)); mx = fmaxf(mx, __shfl_xor(mx, 32));
#pragma unroll
                for (int i = 0; i < 16; ++i)
#pragma unroll
                    for (int k = 0; k < 4; ++k) { S[i][k] = __builtin_amdgcn_exp2f(S[i][k] - mx); l += S[i][k]; }
                l += __shfl_xor(l, 16); l += __shfl_xor(l, 32);
#pragma unroll
                for (int c2 = 0; c2 < 8; ++c2) pf[c2] = pack8(S[2 * c2], S[2 * c2 + 1]);
            }
        } else {
            const int mt = j - 4;
#pragma unroll
            for (int dt = 0; dt < 16; ++dt) {
                const LAS bf16* vr = base + (16 * dt + fr) * VS + 4 * fq;
                O[dt] = mfma16(cat8(*(const LAS u32x2*)vr, *(const LAS u32x2*)(vr + 16)), pf[2 * mt], O[dt]);
                O[dt] = mfma16(cat8(*(const LAS u32x2*)(vr + 32), *(const LAS u32x2*)(vr + 48)), pf[2 * mt + 1], O[dt]);
            }
        }
        if (j < 7) lstore(j + 1);
        __syncthreads();
    }
    const float il = 1.f / l;
#pragma unroll
    for (int dt = 0; dt < 16; ++dt) { u32x2 w; w.x = pk2(O[dt][0] * il, O[dt][1] * il); w.y = pk2(O[dt][2] * il, O[dt][3] * il);
        *(GAS u32x2*)(XO + qrow * DM + h * 256 + 16 * dt + 4 * fq) = w; }
}
#ifndef DUP_ML
#define DUP_ML 1
#endif
#ifndef DUP_IDX
#define DUP_IDX 1
#endif
#ifndef DUP_DSA
#define DUP_DSA 1
#endif
#ifndef DUP_XA
#define DUP_XA 1
#endif
#ifndef DUP_PREP
#define DUP_PREP 1
#endif
#define XB_TMO      128
#define XB_XCNT(j)  (256  + 64 * (j))
#define XB_XSUB(j)  (1280 + 64 * (j))
#define XB_XGEN(j)  (2304 + 64 * (j))
#define XB_TOP      3328
#define XB_TOPGEN   3392
#define XCD_BAR_WORDS 3456
#define XB_SPIN_CAP (1u << 18)

__device__ __forceinline__ unsigned xb_ld(unsigned* p)              { return __hip_atomic_load(p, __ATOMIC_RELAXED, __HIP_MEMORY_SCOPE_AGENT); }
__device__ __forceinline__ unsigned xb_add(unsigned* p, unsigned v) { return __hip_atomic_fetch_add(p, v, __ATOMIC_RELAXED, __HIP_MEMORY_SCOPE_AGENT); }
__device__ __forceinline__ unsigned xb_xcc_id() { return (unsigned)__builtin_amdgcn_s_getreg((3 << 11) | 20) & 0xFu; }
#define XB_SPIN(cond, bar) do { unsigned _sp = 0; while (cond) { __builtin_amdgcn_s_sleep(1); \
    if ((++_sp & 255u) == 0u) { if (xb_ld(&(bar)[XB_TMO])) break; if (_sp > XB_SPIN_CAP) { atomicAdd(&(bar)[XB_TMO], 1u); break; } } } } while (0)

struct XcdBarrier {
    unsigned* bar; unsigned x;
    volatile LAS unsigned* st;
};

__device__ __forceinline__ XcdBarrier xcd_barrier_post(unsigned* bar, volatile LAS unsigned* st) {
    XcdBarrier b; b.bar = bar; b.x = xb_xcc_id(); b.st = st;
    if (threadIdx.x == 0) (void)xb_add(&bar[XB_XCNT(b.x)], 1u);
    return b;
}
__device__ __forceinline__ void xcd_barrier_complete(unsigned* bar, unsigned x, unsigned& nloc, unsigned& nx) {
    const unsigned G = gridDim.x * gridDim.y * gridDim.z;
    unsigned sum, cnt, mine, sp = 0u;
    for (;;) {
        sum = 0u; cnt = 0u; mine = 0u;
#pragma unroll
        for (unsigned j = 0; j < 16; ++j) { const unsigned c = xb_ld(&bar[XB_XCNT(j)]); sum += c; cnt += (c > 0u) ? 1u : 0u; mine = (j == x) ? c : mine; }
        if (sum == G) break;
        __builtin_amdgcn_s_sleep(1);
        if ((++sp & 255u) == 0u) { if (xb_ld(&bar[XB_TMO])) break; if (sp > XB_SPIN_CAP) { atomicAdd(&bar[XB_TMO], 1u); break; } }
    }
    nloc = mine > 0u ? mine : 1u; nx = cnt > 0u ? cnt : 1u;
}

__device__ __forceinline__ void xcd_barrier(const XcdBarrier& b) {
    asm volatile("s_waitcnt vmcnt(0)" ::: "memory");
    __syncthreads();
    if (threadIdx.x == 0) {
        unsigned* bar = b.bar;
        __builtin_amdgcn_s_waitcnt(0);
        unsigned nloc = b.st[0], nx = b.st[1];
        if (nloc == 0u) { xcd_barrier_complete(bar, b.x, nloc, nx); b.st[0] = nloc; b.st[1] = nx; }
        const unsigned old = xb_add(&bar[XB_XSUB(b.x)], 1u);
        const unsigned gen = old / nloc;
        if (old + 1u == (gen + 1u) * nloc) {
            __builtin_amdgcn_fence(__ATOMIC_RELEASE, "agent");
            asm volatile("s_waitcnt vmcnt(0)" ::: "memory");
            const unsigned og = xb_add(&bar[XB_TOP], 1u);
            const unsigned tg = og / nx;
            if (og + 1u == (tg + 1u) * nx) xb_add(&bar[XB_TOPGEN], 1u);
            else XB_SPIN(xb_ld(&bar[XB_TOPGEN]) == tg, bar);
            __builtin_amdgcn_fence(__ATOMIC_ACQUIRE, "agent");
            xb_add(&bar[XB_XGEN(b.x)], 1u);
            asm volatile("s_waitcnt vmcnt(0)" ::: "memory");
        } else {
            XB_SPIN(xb_ld(&bar[XB_XGEN(b.x)]) == gen, bar);
            __builtin_amdgcn_fence(__ATOMIC_ACQUIRE, "agent");
            asm volatile("s_waitcnt vmcnt(0)" ::: "memory");
        }
    }
    __syncthreads();
}


constexpr size_t WS_XBAR = 10 * MiB + 32768 + 8192;
constexpr size_t WS_BAR = 10 * MiB + 32768;
__device__ __forceinline__ void grid_bar(GAS unsigned* cnt, unsigned G, unsigned& epoch) {
    asm volatile("s_waitcnt vmcnt(0)" ::: "memory");
    __syncthreads();
    ++epoch;
    if (threadIdx.x == 0) {
        __builtin_amdgcn_fence(__ATOMIC_RELEASE, "agent");
        asm volatile("s_waitcnt vmcnt(0)" ::: "memory");
        __hip_atomic_fetch_add(cnt, 1u, __ATOMIC_RELAXED, __HIP_MEMORY_SCOPE_AGENT);
        const unsigned target = epoch * G; unsigned spins = 0;
        while (__hip_atomic_load(cnt, __ATOMIC_RELAXED, __HIP_MEMORY_SCOPE_AGENT) < target) { __builtin_amdgcn_s_sleep(1); if (++spins > (1u << 24)) break; }
        __builtin_amdgcn_fence(__ATOMIC_ACQUIRE, "agent");
        asm volatile("s_waitcnt vmcnt(0)" ::: "memory");
    }
    __syncthreads();
}
__device__ __forceinline__ void snake_unit(int i, int c, int nb, int& o) { o = i * nb + ((i & 1) ? nb - 1 - c : c); }

__global__ void __launch_bounds__(512, 2) mk_fwd(Args a) {
    extern __shared__ __attribute__((aligned(16))) unsigned char lds_raw[];
    LAS unsigned char* lds = (LAS unsigned char*)lds_raw;

    int tid = threadIdx.x, lane = tid & 63; const int wave = __builtin_amdgcn_readfirstlane(tid >> 6);
    const int G = gridDim.x, vb = blockIdx.x;
    unsigned char* ws = a.ws;
    typedef pg8::bf16_t bt;
#define FRESH_WS() asm volatile("" : "+s"(ws))
    { volatile LAS unsigned* st0 = (volatile LAS unsigned*)(lds + 131072 + 192); if (threadIdx.x == 0) { st0[0] = 0u; st0[1] = 0u; } __syncthreads();
      (void)xcd_barrier_post((unsigned*)(a.ws + WS_XBAR), st0); }
    { LAS unsigned long long* argl = (LAS unsigned long long*)(lds + 131072);
      if (tid == 0) { argl[0] = (unsigned long long)a.x; argl[1] = (unsigned long long)a.convw; argl[2] = (unsigned long long)a.convb; argl[3] = (unsigned long long)a.ibias;
                      argl[4] = (unsigned long long)a.fbias; argl[5] = (unsigned long long)a.headg; argl[6] = (unsigned long long)a.fing; } }
    p0_prologue(a, lds, vb, G, wave, lane);
    if (a.ws == nullptr) cg::this_grid().sync();
    { XcdBarrier xbr; xbr.bar = (unsigned*)(ws + WS_XBAR); xbr.x = xb_xcc_id(); xbr.st = (volatile LAS unsigned*)(lds + 131072 + 192); xcd_barrier(xbr); } FRESH_WS();
    unsigned epoch = 0; (void)epoch;
    { pg8::Gemm g{(const bt*)(ws + WS_XB), (const bt*)(ws + WS_WGU1), NT, 2 * FF, DM}; pg8::StaticOrder S; S.init(NT, 2 * FF, G, vb);
      pg8::EpiAct E{(bt*)(ws + WS_ACT), (const float*)(ws + WS_PARTX)};
      pg8::gemm_phase<pg8::EpiAct, pg8::StaticOrder, true, true>(lds, g, S, E); }
    { XcdBarrier xbr; xbr.bar = (unsigned*)(ws + WS_XBAR); xbr.x = xb_xcc_id(); xbr.st = (volatile LAS unsigned*)(lds + 131072 + 192); xcd_barrier(xbr); } FRESH_WS();
    { pg8::Gemm g{(const bt*)(ws + WS_ACT), (const bt*)(ws + WS_WD1), NT, DM, FF}; pg8::StaticOrder S; S.init(NT, DM, G, vb);
      pg8::EpiResid<false> E{nullptr, (const bt*)(ws + WS_XB), (bt*)(ws + WS_HB), (float*)(ws + WS_PARTA), 0.5f};
      pg8::gemm_phase<pg8::EpiResid<false>, pg8::StaticOrder, true, true>(lds, g, S, E); }
    { XcdBarrier xbr; xbr.bar = (unsigned*)(ws + WS_XBAR); xbr.x = xb_xcc_id(); xbr.st = (volatile LAS unsigned*)(lds + 131072 + 192); xcd_barrier(xbr); } FRESH_WS();
    { pg8::Gemm g{(const bt*)(ws + WS_HB), (const bt*)(ws + WS_WIN), NT, ZW, DM}; pg8::StaticOrder S; S.init(NT, ZW, G, vb);
      pg8::EpiScale<0> E{(bt*)(ws + WS_Z), ZW, (const float*)(ws + WS_PARTA)};
      pg8::gemm_phase<pg8::EpiScale<0>, pg8::StaticOrder, true, true>(lds, g, S, E); }
    { pg8::Gemm g{(const bt*)(ws + WS_MEMB), (const bt*)(ws + WS_WK), MEMR, DM, DM}; pg8::RangeOrder S; S.init(MEMR / 256, DM / 256, G, vb, 128);
      pg8::EpiScale<1> E{(bt*)(ws + WS_KX), DM, (const float*)(ws + WS_RSTDMEM)};
      pg8::gemm_phase<pg8::EpiScale<1>, pg8::RangeOrder, true, true>(lds, g, S, E); }
    { pg8::Gemm g{(const bt*)(ws + WS_WV), (const bt*)(ws + WS_MEMB), DM, MEMR, DM}; pg8::RangeOrder S; S.init(DM / 256, MEMR / 256, G, vb, 192);
      pg8::EpiScale<2> E{(bt*)(ws + WS_VTX), MEMR, (const float*)(ws + WS_RSTDMEM)};
      pg8::gemm_phase<pg8::EpiScale<2>, pg8::RangeOrder, true, true>(lds, g, S, E); }
    { XcdBarrier xbr; xbr.bar = (unsigned*)(ws + WS_XBAR); xbr.x = xb_xcc_id(); xbr.st = (volatile LAS unsigned*)(lds + 131072 + 192); xcd_barrier(xbr); } FRESH_WS();
    { Args a4{}; a4.ws = ws; for (int u = vb; u < NB * 32 * DUP_PREP; u += G) prep_unit(a4, lds, (u >> 5) & 15, u & 31, tid); }
    { XcdBarrier xbr; xbr.bar = (unsigned*)(ws + WS_XBAR); xbr.x = xb_xcc_id(); xbr.st = (volatile LAS unsigned*)(lds + 131072 + 192); xcd_barrier(xbr); } FRESH_WS();
    {
        Args a5{}; a5.ws = ws;
        const int nml = (G > 64) ? 64 : (G > 1 ? G / 2 : 0);
        if (vb < nml) { for (int u = vb; u < 64 * DUP_ML; u += nml) mlstm_unit(a5, lds, (u >> 2) & 15, u & 3, tid, wave, lane); }
        {
            LAS unsigned long long* maskl = (LAS unsigned long long*)(lds + 135168);
            volatile LAS int* slot = (volatile LAS int*)(lds + 131072 + 128);
            const int x = vb & 7; GAS unsigned* qc = (GAS unsigned*)(ws + WS_BAR) + 64 * (1 + x);
            for (;;) {
                if (tid == 0) *slot = (int)__hip_atomic_fetch_add(qc, 1u, __ATOMIC_RELAXED, __HIP_MEMORY_SCOPE_AGENT);
                __syncthreads();
                const int j = __builtin_amdgcn_readfirstlane(*slot);
                if (j >= 128) break;
                const int bb = 2 * x + (j & 1), qb = 63 - (j >> 1);
                _Pragma("unroll 1") for (int hf = 0; hf < 2; ++hf) { int tu = threadIdx.x; asm volatile("" : "+v"(tu)); indexer_unit(a5, lds, maskl + hf * 512, bb, 2 * qb + hf, wave, tu & 63); }
                { int tu = threadIdx.x; asm volatile("" : "+v"(tu)); dsa_unit32(a5, lds, maskl, bb, qb, tu, wave, tu & 63); }
            }
        }
    }
    { XcdBarrier xbr; xbr.bar = (unsigned*)(ws + WS_XBAR); xbr.x = xb_xcc_id(); xbr.st = (volatile LAS unsigned*)(lds + 131072 + 192); xcd_barrier(xbr); } FRESH_WS();
    { pg8::Gemm g{(const bt*)(ws + WS_Y), (const bt*)(ws + WS_WOUT), NT, DM, DM}; pg8::StaticOrder S; S.init(NT, DM, G, vb);
      pg8::EpiResid<false> E{nullptr, (const bt*)(ws + WS_HB), (bt*)(ws + WS_HB), (float*)(ws + WS_PARTB), 1.0f};
      pg8::gemm_phase<pg8::EpiResid<false>, pg8::StaticOrder, true, true>(lds, g, S, E); }
    { XcdBarrier xbr; xbr.bar = (unsigned*)(ws + WS_XBAR); xbr.x = xb_xcc_id(); xbr.st = (volatile LAS unsigned*)(lds + 131072 + 192); xcd_barrier(xbr); } FRESH_WS();
    { pg8::Gemm g{(const bt*)(ws + WS_HB), (const bt*)(ws + WS_WQ), NT, DM, DM}; pg8::StaticOrder S; S.init(NT, DM, G, vb);
      pg8::EpiScale<0> E{(bt*)(ws + WS_QX), DM, (const float*)(ws + WS_PARTB)};
      pg8::gemm_phase<pg8::EpiScale<0>, pg8::StaticOrder, true, true>(lds, g, S, E); }
    { XcdBarrier xbr; xbr.bar = (unsigned*)(ws + WS_XBAR); xbr.x = xb_xcc_id(); xbr.st = (volatile LAS unsigned*)(lds + 131072 + 192); xcd_barrier(xbr); } FRESH_WS();
    Args a6{}; a6.ws = ws;
    if ((G & 7) == 0) { const int x = vb & 7, r = vb >> 3, nr = G >> 3;
        const int per = (128 + nr - 1) / nr;
        for (int w = r * per; w < 128 && w < (r + 1) * per; ++w) { int tu = threadIdx.x; asm volatile("" : "+v"(tu)); const int pr = x * 8 + (w >> 4); xattn_unit(a6, lds, pr >> 2, pr & 3, w & 15, tu, wave, tu & 63); } }
    else for (int u = vb; u < NB * 4 * 16; u += G) { int tu = threadIdx.x; asm volatile("" : "+v"(tu)); xattn_unit(a6, lds, (u >> 6) & 15, (u >> 4) & 3, u & 15, tu, wave, tu & 63); }
    { XcdBarrier xbr; xbr.bar = (unsigned*)(ws + WS_XBAR); xbr.x = xb_xcc_id(); xbr.st = (volatile LAS unsigned*)(lds + 131072 + 192); xcd_barrier(xbr); } FRESH_WS();
    { pg8::Gemm g{(const bt*)(ws + WS_XO), (const bt*)(ws + WS_WO), NT, DM, DM}; pg8::StaticOrder S; S.init(NT, DM, G, vb);
      pg8::EpiResid<false> E{nullptr, (const bt*)(ws + WS_HB), (bt*)(ws + WS_HB), (float*)(ws + WS_PARTC), 1.0f};
      pg8::gemm_phase<pg8::EpiResid<false>, pg8::StaticOrder, true, true>(lds, g, S, E); }
    { XcdBarrier xbr; xbr.bar = (unsigned*)(ws + WS_XBAR); xbr.x = xb_xcc_id(); xbr.st = (volatile LAS unsigned*)(lds + 131072 + 192); xcd_barrier(xbr); } FRESH_WS();
    { pg8::Gemm g{(const bt*)(ws + WS_HB), (const bt*)(ws + WS_WGU2), NT, 2 * FF, DM}; pg8::StaticOrder S; S.init(NT, 2 * FF, G, vb);
      pg8::EpiAct E{(bt*)(ws + WS_ACT), (const float*)(ws + WS_PARTC)};
      pg8::gemm_phase<pg8::EpiAct, pg8::StaticOrder, true, true>(lds, g, S, E); }
    { XcdBarrier xbr; xbr.bar = (unsigned*)(ws + WS_XBAR); xbr.x = xb_xcc_id(); xbr.st = (volatile LAS unsigned*)(lds + 131072 + 192); xcd_barrier(xbr); } FRESH_WS();
    { pg8::Gemm g{(const bt*)(ws + WS_ACT), (const bt*)(ws + WS_WD2), NT, DM, FF}; pg8::StaticOrder S; S.init(NT, DM, G, vb);
      pg8::EpiResid<false> E{nullptr, (const bt*)(ws + WS_HB), (bt*)(ws + WS_HB), (float*)(ws + WS_PARTD), 0.5f};
      pg8::gemm_phase<pg8::EpiResid<false>, pg8::StaticOrder, true, true>(lds, g, S, E); }
    { XcdBarrier xbr; xbr.bar = (unsigned*)(ws + WS_XBAR); xbr.x = xb_xcc_id(); xbr.st = (volatile LAS unsigned*)(lds + 131072 + 192); xcd_barrier(xbr); } FRESH_WS();
    {
        int tid13 = threadIdx.x; asm volatile("" : "+v"(tid13)); const int lane = tid13 & 63;
        const GAS float* parts = (const GAS float*)(ws + WS_PARTD); const GAS float* fingp = LDPTR(6);
        const GAS bf16* hbp = (const GAS bf16*)(ws + WS_HB);
        f32x4 gg[4];
#pragma unroll
        for (int j = 0; j < 4; ++j) gg[j] = ((const GAS f32x4*)fingp)[lane + 64 * j];
        for (int m0 = 2 * (vb * 8 + wave); m0 < NT; m0 += 2 * G * 8) {
            u32x2 hw[2][4]; float sp[2];
#pragma unroll
            for (int rr = 0; rr < 2; ++rr) { const int m = m0 + rr; sp[rr] = lane < 16 ? parts[(size_t)m * 16 + lane] : 0.f; const GAS u32x2* hr = (const GAS u32x2*)(hbp + (size_t)m * DM) + lane;
#pragma unroll
                for (int j = 0; j < 4; ++j) hw[rr][j] = __builtin_nontemporal_load(&hr[64 * j]); }
#pragma unroll
            for (int rr = 0; rr < 2; ++rr) { const int m = m0 + rr; const float s = wave_sum(sp[rr]); const float rs = rsqrtf(s * (1.f / 1024.f) + EPS);
                GAS f32x4* o = (GAS f32x4*)(a.out + (size_t)m * DM) + lane;
#pragma unroll
                for (int j = 0; j < 4; ++j) { const u32x2 w = hw[rr][j]; const f32x4 v = {bflo(w.x), bfhi(w.x), bflo(w.y), bfhi(w.y)}; __builtin_nontemporal_store(v * rs * gg[j], &o[64 * j]); } }
        }
    }
}

extern "C" void kernel_launch(void* const* d_in, const int* in_sizes, int n_in, void* d_out, int out_size, void* d_ws, size_t ws_size, hipStream_t stream) {
    static int grid = 0;
    if (grid == 0) {
        int dev = 0, cus = 0, per_cu = 0;
        if (n_in != 27 || out_size != NT * DM || ws_size < WS_END) { fprintf(stderr, "kernel_launch: unexpected problem (n_in %d out %d ws %zu)\n", n_in, out_size, ws_size); grid = -1; return; }
        (void)hipGetDevice(&dev);
        (void)hipDeviceGetAttribute(&cus, hipDeviceAttributeMultiprocessorCount, dev);
        (void)hipFuncSetAttribute((const void*)mk_fwd, hipFuncAttributeMaxDynamicSharedMemorySize, LDS_BYTES);
        (void)hipOccupancyMaxActiveBlocksPerMultiprocessor(&per_cu, (const void*)mk_fwd, 512, LDS_BYTES);
        (void)hipGetLastError();
        if (per_cu < 1) per_cu = 1;
        grid = cus > 0 ? cus : 256;
    }
    if (grid < 0) return;
    (void)hipMemsetAsync((char*)d_ws + WS_BAR, 0, 8192 + 16384, stream);
    Args a{};
    const float** f = (const float**)&a;
    for (int i = 0; i < 27; ++i) f[i] = (const float*)d_in[i];
    a.out = (float*)d_out; a.ws = (unsigned char*)d_ws;
    void* args[] = {&a};
    hipError_t e = hipLaunchCooperativeKernel((const void*)mk_fwd, dim3(grid), dim3(512), args, LDS_BYTES, stream);
    if (e != hipSuccess) fprintf(stderr, "cooperative launch failed: %s (grid %d)\n", hipGetErrorString(e), grid);
}
```
